# Optimizing an MI355X kernel written in HIP

```python
import math
import jax
import jax.numpy as jnp
from jax import lax
import numpy as np

D_MODEL = 1024
BATCH = 32
SEQ = 256
DEPTH = 4
DEC_BATCH = 8
DEC_SEQ = 1024
PAST_LEN = 512

GRID_W = 64
HEAD_DIM = 64
A_HEADS = 8
A_KV_HEADS = 4
B_HEADS = 8
MIX_WIDTH = (A_HEADS + B_HEADS) * HEAD_DIM
ATTN_IN = (A_HEADS + 2 * A_KV_HEADS + 3 * B_HEADS) * HEAD_DIM
Q_BLOCK = 128
ROPE_THETA = 10000.0
NA_WIN_H = 8
NA_WIN_W = 16
NA_QCOLS = 16
NA_KCOLS = NA_QCOLS + NA_WIN_W
GLA_HEADS = 4
GLA_DK = D_MODEL // 2 // GLA_HEADS
GLA_DV = D_MODEL // GLA_HEADS
GLA_KDIM = GLA_HEADS * GLA_DK
GLA_VDIM = GLA_HEADS * GLA_DV
GLA_RANK = 16
GLA_GATE_NORM = 16.0
GLA_CHUNK = 64
GLA_IN = 2 * GLA_KDIM + 2 * GLA_VDIM + 2 * GLA_RANK
D_FF = ((8 * D_MODEL // 3 + 127) // 128) * 128
FFN_RES = 0.5
N_MOD = 9
N_ATTN = (DEPTH + 1) // 2
N_GLA = DEPTH // 2
EPS = 1e-6

kernel_name = 'hybrid_flow_prefix_trunk_step'


def rms_norm(x, g):
    xf = x.astype(jnp.float32)
    y = xf * lax.rsqrt(jnp.mean(xf * xf, axis=-1, keepdims=True) + EPS)
    return (y * g.astype(jnp.float32)).astype(x.dtype)


def modulate(h, shift, scale):
    return h * (1 + scale) + shift


def adaln(cond, w, b):
    m = jax.nn.silu(cond) @ w + b
    return m.reshape(m.shape[0], 1, N_MOD, D_MODEL)


def swiglu(h, wg, wu, wd):
    return (jax.nn.silu(h @ wg) * (h @ wu)) @ wd


def ffn_sublayer(x, shift, scale, gate, g, wg, wu, wd):
    h = modulate(rms_norm(x, g), shift, scale)
    return x + FFN_RES * gate * swiglu(h, wg, wu, wd)


def split_last(a, sizes):
    return jnp.split(a, np.cumsum(sizes)[:-1].tolist(), axis=-1)


def axial_rope(x, t):
    half = x.shape[-1] // 2
    freqs = ROPE_THETA ** (-jnp.arange(0, half, 2, dtype=jnp.float32) / half)

    def rot(xp, pos):
        ang = pos.astype(jnp.float32)[:, None] * freqs[None, :]
        cos = jnp.concatenate([jnp.cos(ang), jnp.cos(ang)], -1)[:, None, :]
        sin = jnp.concatenate([jnp.sin(ang), jnp.sin(ang)], -1)[:, None, :]
        xf = xp.astype(jnp.float32)
        x1, x2 = jnp.split(xf, 2, axis=-1)
        return xf * cos + jnp.concatenate([-x2, x1], -1) * sin

    out = jnp.concatenate([rot(x[..., :half], t // GRID_W), rot(x[..., half:], t % GRID_W)], -1)
    return out.astype(x.dtype)


def blocked_attention(q, k, v):
    bsz, t, hq, d = q.shape
    hkv = k.shape[2]
    grp = hq // hkv
    nb = t // Q_BLOCK
    scale = d ** -0.5
    qb = q.reshape(bsz, nb, Q_BLOCK, hkv, grp, d).transpose(1, 0, 3, 4, 2, 5)
    kt = k.transpose(0, 2, 1, 3)
    vt = v.transpose(0, 2, 1, 3)

    def one_block(qi):
        s = jnp.einsum('bhgqd,bhkd->bhgqk', qi, kt).astype(jnp.float32) * scale
        p = jax.nn.softmax(s, axis=-1).astype(v.dtype)
        return jnp.einsum('bhgqk,bhkd->bhgqd', p, vt)

    o = lax.map(one_block, qb)
    return o.transpose(1, 0, 4, 2, 3, 5).reshape(bsz, t, hq, d)


def neighbourhood_attention(q, k, v, k_ctx, v_ctx, rel_bias):
    bsz, t, h, d = q.shape
    rows = t // GRID_W
    wh = min(NA_WIN_H, rows)
    ncb = GRID_W // NA_QCOLS
    scale = d ** -0.5
    r = jnp.arange(rows)
    row_start = jnp.clip(r - wh // 2, 0, rows - wh)
    row_idx = row_start[:, None] + jnp.arange(wh)
    qcol = jnp.arange(GRID_W).reshape(ncb, NA_QCOLS)
    blk_start = jnp.clip(jnp.arange(ncb) * NA_QCOLS - NA_WIN_W // 2, 0, GRID_W - NA_KCOLS)
    col_idx = blk_start[:, None] + jnp.arange(NA_KCOLS)
    win_start = jnp.clip(qcol - NA_WIN_W // 2, 0, GRID_W - NA_WIN_W)
    kc = col_idx[:, None, :]
    in_win = (kc >= win_start[..., None]) & (kc < win_start[..., None] + NA_WIN_W)

    def gather(a):
        g = jnp.take(a.reshape(bsz, rows, GRID_W, h, d), row_idx, axis=1)
        g = jnp.take(g, col_idx, axis=3)
        return g.transpose(0, 5, 1, 3, 2, 4, 6).reshape(bsz, h, rows, ncb, wh * NA_KCOLS, d)

    kg = gather(k)
    vg = gather(v)
    qg = q.reshape(bsz, rows, ncb, NA_QCOLS, h, d).transpose(0, 4, 1, 2, 3, 5)

    dr = row_idx - r[:, None] + NA_WIN_H - 1
    dc = jnp.clip(kc - qcol[..., None] + NA_WIN_W - 1, 0, 2 * NA_WIN_W - 2)
    bias = rel_bias[:, dr[:, None, None, :, None], dc[None, :, :, None, :]]
    bias = bias.reshape(h, rows, ncb, NA_QCOLS, wh * NA_KCOLS).astype(jnp.float32)
    mask = jnp.broadcast_to(in_win[None, :, :, None, :], (rows, ncb, NA_QCOLS, wh, NA_KCOLS))
    mask = mask.reshape(rows, ncb, NA_QCOLS, wh * NA_KCOLS)

    s_win = jnp.einsum('bhrnqd,bhrnkd->bhrnqk', qg, kg).astype(jnp.float32) * scale + bias[None]
    s_win = jnp.where(mask[None, None], s_win, -jnp.inf)
    s_ctx = jnp.einsum('bhrnqd,bkhd->bhrnqk', qg, k_ctx).astype(jnp.float32) * scale
    n_win = s_win.shape[-1]
    p = jax.nn.softmax(jnp.concatenate([s_win, s_ctx], axis=-1), axis=-1).astype(v.dtype)
    o = (jnp.einsum('bhrnqk,bhrnkd->bhrnqd', p[..., :n_win], vg)
         + jnp.einsum('bhrnqk,bkhd->bhrnqd', p[..., n_win:], v_ctx))
    return o.transpose(0, 2, 3, 4, 1, 5).reshape(bsz, t, h, d)


def attn_project(h, w_in):
    bsz, t, _ = h.shape
    parts = split_last(h @ w_in, [A_HEADS * HEAD_DIM, A_KV_HEADS * HEAD_DIM, A_KV_HEADS * HEAD_DIM,
                                  B_HEADS * HEAD_DIM, B_HEADS * HEAD_DIM, B_HEADS * HEAD_DIM])
    return [p.reshape(bsz, t, -1, HEAD_DIM) for p in parts]


def attn_merge(oa, ob, w_out):
    bsz, t = oa.shape[:2]
    return jnp.concatenate([oa.reshape(bsz, t, -1), ob.reshape(bsz, t, -1)], axis=-1) @ w_out


def attn_mixer_ctx(h, w_in, w_out, gq, gk):
    qa, ka, va, qb, kb, vb = attn_project(h, w_in)
    qa = rms_norm(qa, gq)
    ka = rms_norm(ka, gk)
    oa = blocked_attention(qa, ka, va)
    ob = blocked_attention(qb, kb, vb)
    return attn_merge(oa, ob, w_out), ka, va, kb, vb


def attn_mixer_lat(h, t_lat, ka_ctx, va_ctx, kb_ctx, vb_ctx, w_in, w_out, gq, gk, rel_bias):
    qa, ka, va, qb, kb, vb = attn_project(h, w_in)
    qa = axial_rope(rms_norm(qa, gq), t_lat)
    ka = axial_rope(rms_norm(ka, gk), t_lat)
    oa = blocked_attention(qa, jnp.concatenate([ka, ka_ctx], axis=1), jnp.concatenate([va, va_ctx], axis=1))
    ob = neighbourhood_attention(qb, kb, vb, kb_ctx, vb_ctx, rel_bias)
    return attn_merge(oa, ob, w_out)


def gla_chunked(q, k, v, log_g, s0):
    bsz, t, h, _ = q.shape
    n = t // GLA_CHUNK

    def chunks(a):
        return a.reshape(bsz, n, GLA_CHUNK, h, a.shape[-1]).transpose(1, 0, 3, 2, 4)

    qc, kc, vc, gc = chunks(q), chunks(k), chunks(v), chunks(log_g)
    b = jnp.cumsum(gc.astype(jnp.float32), axis=-2)
    b_last = b[..., -1:, :]
    q_in = qc.astype(jnp.float32) * jnp.exp(b)
    k_in = kc.astype(jnp.float32) * jnp.exp(-b)
    k_out = kc.astype(jnp.float32) * jnp.exp(b_last - b)
    causal = jnp.tril(jnp.ones((GLA_CHUNK, GLA_CHUNK), dtype=bool))
    a = jnp.where(causal, jnp.einsum('nbhqd,nbhkd->nbhqk', q_in, k_in), 0.0)
    o_intra = jnp.einsum('nbhqk,nbhkv->nbhqv', a, vc.astype(jnp.float32))
    u = jnp.einsum('nbhkd,nbhkv->nbhdv', k_out, vc.astype(jnp.float32))
    decay = jnp.exp(b_last[..., 0, :])

    def step(s, inp):
        q_i, dec_i, u_i = inp
        o_i = jnp.einsum('bhqd,bhdv->bhqv', q_i, s)
        return s * dec_i[..., None] + u_i, o_i

    s_fin, o_inter = lax.scan(step, s0.astype(jnp.float32), (q_in, decay, u))
    o = (o_intra + o_inter).transpose(1, 0, 3, 2, 4).reshape(bsz, t, h, -1)
    return o.astype(q.dtype), s_fin.astype(q.dtype)


def gla_mixer(h, s0_f, s0_b, w_in, w_gup, b_gup, g_norm, w_out):
    bsz, t, _ = h.shape
    q, k, v, g, d_f, d_b = split_last(h @ w_in, [GLA_KDIM, GLA_KDIM, GLA_VDIM, GLA_VDIM, GLA_RANK, GLA_RANK])
    lg_f = jax.nn.log_sigmoid((d_f @ w_gup[0] + b_gup[0]).astype(jnp.float32)) / GLA_GATE_NORM
    lg_b = jax.nn.log_sigmoid((d_b @ w_gup[1] + b_gup[1]).astype(jnp.float32)) / GLA_GATE_NORM
    heads_k = lambda a: a.reshape(bsz, t, GLA_HEADS, GLA_DK)
    q = heads_k(q) * (GLA_DK ** -0.5)
    k = heads_k(k)
    v = v.reshape(bsz, t, GLA_HEADS, GLA_DV)
    lg_f, lg_b = heads_k(lg_f), heads_k(lg_b)
    rev = lambda a: a[:, ::-1]
    o_f, s_f = gla_chunked(q, k, v, lg_f, s0_f)
    o_b, s_b = gla_chunked(rev(q), rev(k), rev(v), rev(lg_b), s0_b)
    o = rms_norm(o_f + rev(o_b), g_norm).reshape(bsz, t, GLA_VDIM) * jax.nn.silu(g)
    return o @ w_out, s_f, s_b


def setup_inputs(seed: int = 0) -> dict:
    key = jax.random.key(seed)
    ks = jax.random.split(key, 26)

    def nrm(k, shape, s=1.0):
        return jax.random.normal(k, shape, jnp.float32) * s

    def gain(k, shape):
        return 1.0 + nrm(k, shape, 0.05)

    return {
        'x_prompt': nrm(ks[0], (BATCH, SEQ, D_MODEL)),
        'x_sample': nrm(ks[1], (DEC_BATCH, DEC_SEQ, D_MODEL)),
        'cache_a_k': nrm(ks[2], (DEC_BATCH, N_ATTN, PAST_LEN, A_KV_HEADS, HEAD_DIM)),
        'cache_a_v': nrm(ks[3], (DEC_BATCH, N_ATTN, PAST_LEN, A_KV_HEADS, HEAD_DIM)),
        'cache_b_k': nrm(ks[4], (DEC_BATCH, N_ATTN, PAST_LEN, B_HEADS, HEAD_DIM)),
        'cache_b_v': nrm(ks[5], (DEC_BATCH, N_ATTN, PAST_LEN, B_HEADS, HEAD_DIM)),
        'state_gla': nrm(ks[6], (DEC_BATCH, N_GLA, 2, GLA_HEADS, GLA_DK, GLA_DV)),
        'c': nrm(ks[7], (DEC_BATCH, D_MODEL)),
        'c_ctx': nrm(ks[8], (D_MODEL,)),
        'w_mod': nrm(ks[9], (DEPTH, D_MODEL, N_MOD * D_MODEL), 0.5 * D_MODEL ** -0.5),
        'b_mod': nrm(ks[10], (DEPTH, N_MOD * D_MODEL), 0.02),
        'g_norm': gain(ks[11], (DEPTH, 3, D_MODEL)),
        'w_ffn_gate': nrm(ks[12], (DEPTH, 2, D_MODEL, D_FF), D_MODEL ** -0.5),
        'w_ffn_up': nrm(ks[13], (DEPTH, 2, D_MODEL, D_FF), D_MODEL ** -0.5),
        'w_ffn_down': nrm(ks[14], (DEPTH, 2, D_FF, D_MODEL), D_FF ** -0.5),
        'w_attn_in': nrm(ks[15], (N_ATTN, D_MODEL, ATTN_IN), D_MODEL ** -0.5),
        'w_attn_out': nrm(ks[16], (N_ATTN, MIX_WIDTH, D_MODEL), MIX_WIDTH ** -0.5),
        'g_qnorm': gain(ks[17], (N_ATTN, HEAD_DIM)),
        'g_knorm': gain(ks[18], (N_ATTN, HEAD_DIM)),
        'na_rel_bias': nrm(ks[19], (N_ATTN, B_HEADS, 2 * NA_WIN_H - 1, 2 * NA_WIN_W - 1), 0.1),
        'w_gla_in': nrm(ks[20], (N_GLA, D_MODEL, GLA_IN), D_MODEL ** -0.5),
        'w_gla_gup': nrm(ks[21], (N_GLA, 2, GLA_RANK, GLA_KDIM), GLA_RANK ** -0.5),
        'b_gla_gup': nrm(ks[22], (N_GLA, 2, GLA_KDIM), 0.1),
        'g_gla_norm': gain(ks[23], (N_GLA, GLA_DV)),
        'w_gla_out': nrm(ks[24], (N_GLA, GLA_VDIM, D_MODEL), GLA_VDIM ** -0.5),
        'g_final': gain(ks[25], (D_MODEL,)),
    }


def reference(x_prompt, x_sample, cache_a_k, cache_a_v, cache_b_k, cache_b_v, state_gla, c, c_ctx,
              w_mod, b_mod, g_norm, w_ffn_gate, w_ffn_up, w_ffn_down, w_attn_in, w_attn_out,
              g_qnorm, g_knorm, na_rel_bias, w_gla_in, w_gla_gup, b_gla_gup, g_gla_norm, w_gla_out, g_final):
    t_lat = jnp.arange(x_sample.shape[1])
    xp, xs = x_prompt, x_sample
    new_a_k, new_a_v, new_b_k, new_b_v, new_gla = [], [], [], [], []
    for l in range(DEPTH):
        mp = adaln(c_ctx[None, :], w_mod[l], b_mod[l])
        ms = adaln(c, w_mod[l], b_mod[l])
        xp = ffn_sublayer(xp, mp[:, :, 0], mp[:, :, 1], mp[:, :, 2], g_norm[l, 0],
                          w_ffn_gate[l, 0], w_ffn_up[l, 0], w_ffn_down[l, 0])
        xs = ffn_sublayer(xs, ms[:, :, 0], ms[:, :, 1], ms[:, :, 2], g_norm[l, 0],
                          w_ffn_gate[l, 0], w_ffn_up[l, 0], w_ffn_down[l, 0])
        hp = modulate(rms_norm(xp, g_norm[l, 1]), mp[:, :, 3], mp[:, :, 4])
        hs = modulate(rms_norm(xs, g_norm[l, 1]), ms[:, :, 3], ms[:, :, 4])
        if l % 2 == 0:
            i = l // 2
            op, ka, va, kb, vb = attn_mixer_ctx(hp, w_attn_in[i], w_attn_out[i], g_qnorm[i], g_knorm[i])
            os_ = attn_mixer_lat(hs, t_lat, cache_a_k[:, i], cache_a_v[:, i], cache_b_k[:, i], cache_b_v[:, i],
                                 w_attn_in[i], w_attn_out[i], g_qnorm[i], g_knorm[i], na_rel_bias[i])
            new_a_k.append(ka)
            new_a_v.append(va)
            new_b_k.append(kb)
            new_b_v.append(vb)
        else:
            j = l // 2
            zero = jnp.zeros((xp.shape[0], GLA_HEADS, GLA_DK, GLA_DV), xp.dtype)
            op, s_f, s_b = gla_mixer(hp, zero, zero, w_gla_in[j], w_gla_gup[j], b_gla_gup[j],
                                     g_gla_norm[j], w_gla_out[j])
            os_, _, _ = gla_mixer(hs, state_gla[:, j, 0], state_gla[:, j, 1], w_gla_in[j], w_gla_gup[j],
                                  b_gla_gup[j], g_gla_norm[j], w_gla_out[j])
            new_gla.append(jnp.stack([s_f, s_b], axis=1))
        xp = xp + mp[:, :, 5] * op
        xs = xs + ms[:, :, 5] * os_
        xp = ffn_sublayer(xp, mp[:, :, 6], mp[:, :, 7], mp[:, :, 8], g_norm[l, 2],
                          w_ffn_gate[l, 1], w_ffn_up[l, 1], w_ffn_down[l, 1])
        xs = ffn_sublayer(xs, ms[:, :, 6], ms[:, :, 7], ms[:, :, 8], g_norm[l, 2],
                          w_ffn_gate[l, 1], w_ffn_up[l, 1], w_ffn_down[l, 1])
    y_prompt = rms_norm(xp, g_final)
    y_sample = rms_norm(xs, g_final)
    return (y_prompt, y_sample, jnp.stack(new_a_k, axis=1), jnp.stack(new_a_v, axis=1),
            jnp.stack(new_b_k, axis=1), jnp.stack(new_b_v, axis=1), jnp.stack(new_gla, axis=1))
```

```cpp
#include <hip/hip_runtime.h>
#include <hip/hip_cooperative_groups.h>
#include <cstdio>
#include <cstdint>
namespace cg = cooperative_groups;

typedef unsigned short bf16_t;
typedef short bf16x8 __attribute__((ext_vector_type(8)));
typedef short s16x4 __attribute__((ext_vector_type(4)));
typedef float f32x4 __attribute__((ext_vector_type(4)));
typedef float f32x16 __attribute__((ext_vector_type(16)));
typedef unsigned u32x4 __attribute__((ext_vector_type(4)));
typedef unsigned u32x2 __attribute__((ext_vector_type(2)));
#define DI __device__ __forceinline__

constexpr int D = 1024, NTOK = 16384, NP = 8192, DFF = 2816, NMOD = 9;
constexpr int KSLOTS = 20480;
constexpr float EPS = 1e-6f;
constexpr long OFF_YP = 0, OFF_AK = 16777216, OFF_AV = 20971520, OFF_BK = 25165824, OFF_BV = 33554432, OFF_GLA = 41943040;
constexpr size_t WS_X = 0, WS_H = 67108864, WS_O = 100663296, WS_Q = 134217728, WS_KA = 167772160, WS_VTA = 178257920,
                 WS_KB = 188743680, WS_VTB = 209715200, WS_BIG = 230686720, WS_MOD = 400556032, WS_BAR = 402653184 - 16384, WS_W = 402653184;
constexpr size_t BIG_GLABUF = 0, BIG_OF = 100663296, BIG_OB = 134217728, BIG_DG = 167772160;
constexpr size_t W_UP = 0, W_UP_STRIDE = 11534336, W_AIN = 92274688, W_AIN_STRIDE = 5242880, W_GIN = 102760448, W_GIN_STRIDE = 6815744;
constexpr size_t W_DOWN = 116391936, W_DOWN_STRIDE = 5767168, W_AOUT = 162529280, W_GOUT = 166723584, W_OUT_STRIDE = 2097152;
constexpr int NCONS = 56832;
constexpr size_t WS_SH = WS_W + 170917888, WS_SW = WS_SH + 524288, WS_RS = WS_SW + 2097152;

struct Params {
  const float *x_prompt, *x_sample, *cache_a_k, *cache_a_v, *cache_b_k, *cache_b_v, *state_gla, *c, *c_ctx, *w_mod, *b_mod, *g_norm,
      *w_ffn_gate, *w_ffn_up, *w_ffn_down, *w_attn_in, *w_attn_out, *g_qnorm, *g_knorm, *na_rel_bias, *w_gla_in, *w_gla_gup, *b_gla_gup,
      *g_gla_norm, *w_gla_out, *g_final;
  float* out;
  char* ws;
};

typedef float f32x2 __attribute__((ext_vector_type(2)));
typedef __bf16 nbf16x2 __attribute__((ext_vector_type(2)));
DI unsigned pk2(float lo, float hi) { f32x2 v = {lo, hi}; return __builtin_bit_cast(unsigned, __builtin_convertvector(v, nbf16x2)); }
DI unsigned short f2bf(float x) { return (unsigned short)(pk2(x, x) & 0xffffu); }
DI float bf2f(unsigned short b) { return __uint_as_float(((unsigned)b) << 16); }
DI float silu_f(float x) { return x * __builtin_amdgcn_rcpf(1.f + __builtin_amdgcn_exp2f(-1.4426950408889634f * x)); }
DI int crow(int reg, int hh) { return (reg & 3) + 8 * (reg >> 2) + 4 * hh; }
DI bf16x8 pack8(float a, float b, float c, float d, float e, float f, float g, float h) {
  u32x4 p; p.x = pk2(a, b); p.y = pk2(c, d); p.z = pk2(e, f); p.w = pk2(g, h); return __builtin_bit_cast(bf16x8, p);
}
DI bf16x8 pack_lo(const f32x16& x) { return pack8(x[0], x[1], x[2], x[3], x[4], x[5], x[6], x[7]); }
DI bf16x8 pack_hi(const f32x16& x) { return pack8(x[8], x[9], x[10], x[11], x[12], x[13], x[14], x[15]); }
DI bf16x8 join4(s16x4 lo, s16x4 hi) { return __builtin_shufflevector(lo, hi, 0, 1, 2, 3, 4, 5, 6, 7); }
#define MFMA32(a, b, c) __builtin_amdgcn_mfma_f32_32x32x16_bf16((a), (b), (c), 0, 0, 0)
DI f32x16 zero16() { f32x16 z; for (int i = 0; i < 16; ++i) z[i] = 0.f; return z; }
DI int opaque_tid(int wv) {
  int lane; asm volatile("v_mbcnt_lo_u32_b32 %0, -1, 0\n\tv_mbcnt_hi_u32_b32 %0, -1, %0" : "=v"(lane));
  int w = wv; asm volatile("" : "+s"(w));
  return w * 64 + lane; }
DI float shx(float v, int m, int lane) { return __int_as_float(__builtin_amdgcn_ds_bpermute((lane ^ m) << 2, __float_as_int(v))); }
DI int cond_of_row(int row) { return row < NP ? 0 : 1 + ((row - NP) >> 10); }

constexpr int BM = 256, BK = 64, HALF = 128, NXCD = 8, WGM = 8, HT = HALF * BK;
DI int lds_byte(int r, int c) { int st = (r >> 4) * 2 + (c >> 5), rr = r & 15, cc = c & 31, ob = rr * 64 + cc * 2; return st * 1024 + (ob ^ (((ob >> 9) & 1) << 5)); }
DI void stage_rc(int b, int& R, int& C) { int st = b / 1024, sb = b % 1024, swz = sb ^ (((sb >> 9) & 1) << 5); R = (st >> 1) * 16 + swz / 64; C = (st & 1) * 32 + (swz % 64) / 2; }

DI void glds16(const char* sbase, unsigned voff, unsigned ldsdst) {
  unsigned keep;
  asm volatile("s_mov_b32 %0, m0\n\ts_mov_b32 m0, %3\n\ts_nop 0\n\tglobal_load_lds_dwordx4 %1, %2\n\ts_mov_b32 m0, %0" : "=&s"(keep) : "v"(voff), "s"(sbase), "s"(ldsdst) : "memory");
}
template <class Epi>
__device__ __forceinline__ void gemm_phase(const bf16_t* __restrict__ A, const bf16_t* __restrict__ Bt, int M, int N, int K, const Epi epi, int wv) {
  extern __shared__ __attribute__((aligned(16))) char smem[];
  bf16_t* shm = (bf16_t*)smem;
#define SA(b, h) (shm + ((b) * 2 + (h)) * HT)
#define SB(b, h) (shm + (4 + (b) * 2 + (h)) * HT)
#define STAGE(P, BASE, br, kt) do { const char* _sb = (const char*)(BASE) + ((long)(br) * K + (long)(kt) * BK) * 2; \
      const unsigned _ld = ldsw + (unsigned)((const char*)(P) - (const char*)shm); \
      glds16(_sb, voff0, _ld); glds16(_sb, voff1, _ld + 8192u); } while (0)
#define LDA(dst, b, h) for (int m = 0; m < 4; ++m) for (int k = 0; k < 2; ++k) \
    dst[m][k] = *reinterpret_cast<const bf16x8*>((char*)SA(b, h) + lds_byte(wr * 64 + m * 16 + fr, k * 32 + fq * 8))
#define LDB(dst, b, h) for (int n = 0; n < 2; ++n) for (int k = 0; k < 2; ++k) \
    dst[n][k] = *reinterpret_cast<const bf16x8*>((char*)SB(b, h) + lds_byte(wc * 32 + n * 16 + fr, k * 32 + fq * 8))
#define MMA(ai, bj, Atf, Btf) do { __builtin_amdgcn_s_setprio(1); \
    for (int m = 0; m < 4; ++m) for (int n = 0; n < 2; ++n) for (int k = 0; k < 2; ++k) \
      acc[ai][bj][m][n] = __builtin_amdgcn_mfma_f32_16x16x32_bf16(Btf[n][k], Atf[m][k], acc[ai][bj][m][n], 0, 0, 0); \
    __builtin_amdgcn_s_setprio(0); } while (0)
#define WAIT_V(n) asm volatile("s_waitcnt vmcnt(" #n ")" ::: "memory")
#define WAIT_L(n) asm volatile("s_waitcnt lgkmcnt(" #n ")" ::: "memory")
#define BAR __builtin_amdgcn_s_barrier()
#define SCHED __builtin_amdgcn_sched_barrier(0)
  const int nM = M / BM, nN = N / BM, nwg = nM * nN;
  const int tidg = opaque_tid(wv);
  const int wid = tidg >> 6, lane = tidg & 63, wr = wid >> 2, wc = wid & 3, fr = lane & 15, fq = lane >> 4;
  const int nt = K / BK;
  unsigned voff0, voff1;
  const unsigned ldsw = (unsigned)(size_t)smem + (unsigned)__builtin_amdgcn_readfirstlane(wid) * 1024u;
  { int _r, _c; stage_rc(tidg * 16, _r, _c); voff0 = (unsigned)(_r * K + _c) * 2u; stage_rc(tidg * 16 + 8192, _r, _c); voff1 = (unsigned)(_r * K + _c) * 2u; }
#define TILE_RC(Lx, BR, BC) do { int wgid = (Lx); \
    { int q = nwg / NXCD, r = nwg % NXCD, xcd = wgid % NXCD, off = wgid / NXCD; wgid = (xcd < r ? xcd * (q + 1) : r * (q + 1) + (xcd - r) * q) + off; } \
    int nig = WGM * nN, gid = wgid / nig, fm = gid * WGM, gsz = min(nM - fm, WGM); \
    BR = (fm + ((wgid % nig) % gsz)) * BM; BC = ((wgid % nig) / gsz) * BM; } while (0)
  int L = blockIdx.x, brow = 0, bcol = 0;
  if (L < nwg) { TILE_RC(L, brow, bcol);
    STAGE(SB(0, 0), Bt, bcol, 0); STAGE(SA(0, 0), A, brow, 0); STAGE(SB(0, 1), Bt, bcol + HALF, 0); STAGE(SA(0, 1), A, brow + HALF, 0);
    STAGE(SB(1, 0), Bt, bcol, 1); STAGE(SA(1, 0), A, brow, 1); STAGE(SB(1, 1), Bt, bcol + HALF, 1); }
  while (L < nwg) {
    f32x4 acc[2][2][4][2];
    for (int a = 0; a < 2; ++a) for (int b = 0; b < 2; ++b) for (int m = 0; m < 4; ++m) for (int n = 0; n < 2; ++n) acc[a][b][m][n] = (f32x4){0.f, 0.f, 0.f, 0.f};
    bf16x8 At[4][2], B0[2][2], B1[2][2];
    if (wr == 1) BAR;
    WAIT_V(0); BAR;
    BAR;
    for (int t = 0; t < nt - 2; t += 2) {
      LDB(B0, 0, 0); SCHED; LDA(At, 0, 0); STAGE(SA(1, 1), A, brow + HALF, t + 1);
      WAIT_L(8); BAR; WAIT_L(0); MMA(0, 0, At, B0); BAR; SCHED;
      LDB(B1, 0, 1); STAGE(SB(0, 0), Bt, bcol, t + 2);
      BAR; WAIT_L(0); MMA(0, 1, At, B1); BAR;
      LDA(At, 0, 1); STAGE(SA(0, 0), A, brow, t + 2);
      BAR; WAIT_L(0); MMA(1, 0, At, B0); BAR; SCHED;
      STAGE(SB(0, 1), Bt, bcol + HALF, t + 2);
      WAIT_V(6); BAR; MMA(1, 1, At, B1); BAR;
      LDB(B0, 1, 0); SCHED; LDA(At, 1, 0); STAGE(SA(0, 1), A, brow + HALF, t + 2);
      WAIT_L(8); BAR; WAIT_L(0); MMA(0, 0, At, B0); BAR; SCHED;
      LDB(B1, 1, 1); STAGE(SB(1, 0), Bt, bcol, t + 3);
      BAR; WAIT_L(0); MMA(0, 1, At, B1); BAR;
      LDA(At, 1, 1); STAGE(SA(1, 0), A, brow, t + 3);
      BAR; WAIT_L(0); MMA(1, 0, At, B0); BAR; SCHED;
      STAGE(SB(1, 1), Bt, bcol + HALF, t + 3);
      WAIT_V(6); BAR; MMA(1, 1, At, B1); BAR;
    }
    { LDB(B0, 0, 0); LDA(At, 0, 0); STAGE(SA(1, 1), A, brow + HALF, nt - 1);
      BAR; WAIT_L(0); MMA(0, 0, At, B0); BAR;
      LDB(B1, 0, 1); BAR; WAIT_L(0); MMA(0, 1, At, B1); BAR;
      LDA(At, 0, 1); WAIT_V(4); BAR; WAIT_L(0); MMA(1, 0, At, B0); MMA(1, 1, At, B1); BAR; }
    { LDB(B0, 1, 0); LDA(At, 1, 0); WAIT_V(2); BAR; WAIT_L(0); MMA(0, 0, At, B0); BAR;
      LDB(B1, 1, 1); WAIT_V(0); BAR; WAIT_L(0); MMA(0, 1, At, B1); BAR;
      LDA(At, 1, 1); BAR; WAIT_L(0); MMA(1, 0, At, B0); MMA(1, 1, At, B1); BAR; }
    if (wr == 0) BAR;
    const int Ln = L + gridDim.x; int nbrow = 0, nbcol = 0;
    if (Ln < nwg) { TILE_RC(Ln, nbrow, nbcol);
      STAGE(SB(0, 0), Bt, nbcol, 0); STAGE(SA(0, 0), A, nbrow, 0); STAGE(SB(0, 1), Bt, nbcol + HALF, 0); STAGE(SA(0, 1), A, nbrow + HALF, 0);
      STAGE(SB(1, 0), Bt, nbcol, 1); STAGE(SA(1, 0), A, nbrow, 1); STAGE(SB(1, 1), Bt, nbcol + HALF, 1); }
    { const int t2 = opaque_tid(wv); const int wid2 = t2 >> 6, lane2 = t2 & 63; epi(acc, brow, bcol, wid2 >> 2, wid2 & 3, lane2 & 15, lane2 >> 4); }
    L = Ln; brow = nbrow; bcol = nbcol;
  }
#undef TILE_RC
#undef SA
#undef SB
#undef STAGE
#undef LDA
#undef LDB
#undef MMA
}

DI float rstd_of(const float* rs, int row) { const f32x4 q = *(const f32x4*)(rs + (size_t)row * 4); return rsqrtf((q[0] + q[1] + q[2] + q[3]) * (1.f / 1024.f) + EPS); }
struct EpiSwiGLU {
  bf16_t* act; const float* rs; const float* sw;
  DI void operator()(const f32x4 (&acc)[2][2][4][2], int brow, int bcol, int wr, int wc, int fr, int fq) const {
    const float* swp = sw + (size_t)cond_of_row(brow) * NCONS + bcol + 64 * wc + 4 * fq;
    f32x4 sv[2][2];
    _Pragma("unroll") for (int bj = 0; bj < 2; ++bj) _Pragma("unroll") for (int n = 0; n < 2; ++n) sv[bj][n] = *(const f32x4*)(swp + 32 * bj + 16 * n);
    _Pragma("unroll") for (int ai = 0; ai < 2; ++ai) _Pragma("unroll") for (int m = 0; m < 4; ++m) {
      const int row = brow + ai * 128 + wr * 64 + m * 16 + fr;
      const float rstd = rstd_of(rs, row);
      u32x4 w4;
      { f32x4 g = acc[ai][0][m][0] * rstd + sv[0][0], u = acc[ai][0][m][1] * rstd + sv[0][1];
        w4.x = pk2(silu_f(g[0]) * u[0], silu_f(g[1]) * u[1]); w4.y = pk2(silu_f(g[2]) * u[2], silu_f(g[3]) * u[3]); }
      { f32x4 g = acc[ai][1][m][0] * rstd + sv[1][0], u = acc[ai][1][m][1] * rstd + sv[1][1];
        w4.z = pk2(silu_f(g[0]) * u[0], silu_f(g[1]) * u[1]); w4.w = pk2(silu_f(g[2]) * u[2], silu_f(g[3]) * u[3]); }
      *(u32x4*)(act + (size_t)row * DFF + ((bcol >> 6) + wc) * 32 + 8 * fq) = w4;
    }
  }
};
struct EpiResid {
  char* ws; const float* gate  ; const float* gnorm; int nid;
  DI void operator()(const f32x4 (&acc)[2][2][4][2], int brow, int bcol, int wr, int wc, int fr, int fq) const {
    __shared__ float s_part[4][256];
    float* X = (float*)(ws + WS_X); bf16_t* XG = (bf16_t*)(ws + WS_H);
    const bool hn = nid < 12; const int nn = hn ? nid : 0;
    float* rs = (float*)(ws + WS_RS) + (size_t)nn * (NTOK * 4);
    const float* ng = gnorm + nn * D;
    const int cond = cond_of_row(brow);
    const float* nsc = (const float*)(ws + WS_MOD) + (size_t)(nn / 3) * 9 * (NMOD * D) + ((nn % 3) * 3 + 1) * D + (size_t)cond * (NMOD * D);
    const int c0 = bcol + 64 * wc + 4 * fq;
    const float* gp = gate + (size_t)cond * (NMOD * D) + c0;
    float* xb = X + (size_t)(brow + wr * 64 + fr) * D + c0;
    float ss[2][4];
    _Pragma("unroll") for (int ai = 0; ai < 2; ++ai) _Pragma("unroll") for (int m = 0; m < 4; ++m) ss[ai][m] = 0.f;
    _Pragma("unroll") for (int bj = 0; bj < 2; ++bj) _Pragma("unroll") for (int n = 0; n < 2; ++n) {
      const int co = 32 * bj + 16 * n;
      const f32x4 gv = *(const f32x4*)(gp + co);
      f32x4 gm = {0.f, 0.f, 0.f, 0.f};
      if (hn) gm = *(const f32x4*)(ng + c0 + co) * (*(const f32x4*)(nsc + c0 + co) + 1.f);
      _Pragma("unroll") for (int ai = 0; ai < 2; ++ai) _Pragma("unroll") for (int m = 0; m < 4; ++m) {
        f32x4* xp = (f32x4*)(xb + (size_t)(ai * 128 + m * 16) * D + co);
        const f32x4 xn = *xp + gv * acc[ai][bj][m][n];
        *xp = xn;
        if (hn) { ss[ai][m] += xn[0] * xn[0] + xn[1] * xn[1] + xn[2] * xn[2] + xn[3] * xn[3];
          const f32x4 h = xn * gm; u32x2 w; w.x = pk2(h[0], h[1]); w.y = pk2(h[2], h[3]);
          *(u32x2*)(XG + (size_t)(brow + ai * 128 + wr * 64 + m * 16 + fr) * D + c0 + co) = w; }
      }
    }
    if (hn) {
      const int lane = fr + 16 * fq;
      _Pragma("unroll") for (int ai = 0; ai < 2; ++ai) _Pragma("unroll") for (int m = 0; m < 4; ++m) {
        float v = ss[ai][m]; v += shx(v, 16, lane); v += shx(v, 32, lane);
        if (fq == 0) s_part[wc][ai * 128 + wr * 64 + m * 16 + fr] = v; }
      __syncthreads();
      const int t = wr * 256 + wc * 64 + lane;
      if (t < 256) rs[(size_t)(brow + t) * 4 + (bcol >> 8)] = s_part[0][t] + s_part[1][t] + s_part[2][t] + s_part[3][t];
    }
  }
};
struct EpiGlaIn {
  bf16_t* buf; float* dg; const float* rs; const float* sw;
  DI void operator()(const f32x4 (&acc)[2][2][4][2], int brow, int bcol, int wr, int wc, int fr, int fq) const {
    const float* swp = sw + (size_t)cond_of_row(brow) * NCONS + bcol + 64 * wc + 4 * fq;
    f32x4 sv[2][2];
    _Pragma("unroll") for (int bj = 0; bj < 2; ++bj) _Pragma("unroll") for (int n = 0; n < 2; ++n) sv[bj][n] = *(const f32x4*)(swp + 32 * bj + 16 * n);
    _Pragma("unroll") for (int ai = 0; ai < 2; ++ai) _Pragma("unroll") for (int m = 0; m < 4; ++m) {
      const int row = brow + ai * 128 + wr * 64 + m * 16 + fr;
      const float rstd = rstd_of(rs, row);
      if (bcol < 3072) {
        _Pragma("unroll") for (int bj = 0; bj < 2; ++bj) {
          const f32x4 v0 = acc[ai][bj][m][0] * rstd + sv[bj][0], v1 = acc[ai][bj][m][1] * rstd + sv[bj][1];
          u32x4 w; w.x = pk2(v0[0], v0[1]); w.y = pk2(v0[2], v0[3]); w.z = pk2(v1[0], v1[1]); w.w = pk2(v1[2], v1[3]);
          *(u32x4*)(buf + (size_t)row * 3072 + bcol + 64 * wc + 32 * bj + 8 * fq) = w;
        }
      } else if (wc == 0) {
        for (int n = 0; n < 2; ++n) *(f32x4*)(dg + (size_t)row * 32 + 8 * fq + 4 * n) = acc[ai][0][m][n] * rstd + sv[0][n];
      }
    }
  }
};
struct EpiPlain {
  bf16_t* buf; int ldc; const float* rs; const float* sw;
  DI void operator()(const f32x4 (&acc)[2][2][4][2], int brow, int bcol, int wr, int wc, int fr, int fq) const {
    const float* swp = sw + (size_t)cond_of_row(brow) * NCONS + bcol + 64 * wc + 4 * fq;
    f32x4 sv[2][2];
    _Pragma("unroll") for (int bj = 0; bj < 2; ++bj) _Pragma("unroll") for (int n = 0; n < 2; ++n) sv[bj][n] = *(const f32x4*)(swp + 32 * bj + 16 * n);
    _Pragma("unroll") for (int ai = 0; ai < 2; ++ai) _Pragma("unroll") for (int m = 0; m < 4; ++m) {
      const int row = brow + ai * 128 + wr * 64 + m * 16 + fr;
      const float rstd = rstd_of(rs, row);
      _Pragma("unroll") for (int bj = 0; bj < 2; ++bj) {
        const f32x4 v0 = acc[ai][bj][m][0] * rstd + sv[bj][0], v1 = acc[ai][bj][m][1] * rstd + sv[bj][1];
        u32x4 w; w.x = pk2(v0[0], v0[1]); w.y = pk2(v0[2], v0[3]); w.z = pk2(v1[0], v1[1]); w.w = pk2(v1[2], v1[3]);
        *(u32x4*)(buf + (size_t)row * ldc + bcol + 64 * wc + 32 * bj + 8 * fq) = w;
      }
    }
  }
};
struct EpiSW {
  float* sw;
  DI void operator()(const f32x4 (&acc)[2][2][4][2], int brow, int bcol, int wr, int wc, int fr, int fq) const {
    const int inst = bcol < 45056 ? bcol / 5632 : (bcol < 50176 ? 8 + (bcol - 45056) / 2560 : 10 + (bcol - 50176) / 3328);
    _Pragma("unroll") for (int m = 0; m < 4; ++m) {
      const int row = wr * 64 + m * 16 + fr;
      const int c = row - inst * 9;
      if (c >= 0 && c < 9) {
        _Pragma("unroll") for (int bj = 0; bj < 2; ++bj) _Pragma("unroll") for (int n = 0; n < 2; ++n)
          *(f32x4*)(sw + (size_t)c * NCONS + bcol + 64 * wc + 32 * bj + 16 * n + 4 * fq) = acc[0][bj][m][n];
      }
    }
  }
};

DI void qkv_post_phase(const Params& p, int i, int wv) {
  extern __shared__ __attribute__((aligned(16))) char smem[];
  const bf16_t* RAW = (const bf16_t*)(p.ws + WS_BIG);
  bf16_t* Q = (bf16_t*)(p.ws + WS_Q); bf16_t* KA = (bf16_t*)(p.ws + WS_KA); bf16_t* VTA = (bf16_t*)(p.ws + WS_VTA); bf16_t* KB = (bf16_t*)(p.ws + WS_KB); bf16_t* VTB = (bf16_t*)(p.ws + WS_VTB);
  float* oak = p.out + OFF_AK + (size_t)i * 256 * 256; float* oav = p.out + OFF_AV + (size_t)i * 256 * 256; float* obk = p.out + OFF_BK + (size_t)i * 256 * 512; float* obv = p.out + OFF_BV + (size_t)i * 256 * 512;
  const int tid = opaque_tid(wv); const int w = tid >> 6, d = tid & 63;
  const float gqd = p.g_qnorm[i * 64 + d], gkd = p.g_knorm[i * 64 + d];
  const float frq = __expf(-(float)(d & 15) * (9.210340371976184f / 16.f));
  for (int grp = blockIdx.x; grp < NTOK / 64; grp += gridDim.x) {
    const int g0 = grp * 64, row0 = g0 + w * 8;
    const bool lat = g0 >= NP;
    int b, tg0, kbase, Tk;
    if (lat) { b = (g0 - NP) >> 10; tg0 = (g0 - NP) & 1023; kbase = NP + b * 1536; Tk = 1536; } else { b = g0 >> 8; tg0 = g0 & 255; kbase = b * 256; Tk = 256; }
    const int t0 = tg0 + w * 8;
    float cs[8], sn[8];
    _Pragma("unroll") for (int rr = 0; rr < 8; ++rr) { const int t = t0 + rr; const float pos = (float)((d < 32) ? (t >> 6) : (t & 63)); const float ang = pos * frq; cs[rr] = __cosf(ang); sn[rr] = __sinf(ang); }
    const bf16_t* rp = RAW + (size_t)row0 * 2560 + d;
    for (int h = 0; h < 40; ++h) {
      float v[8];
      _Pragma("unroll") for (int rr = 0; rr < 8; ++rr) v[rr] = bf2f(rp[(size_t)rr * 2560 + h * 64]);
      int type, head;
      if (h < 8) { type = 0; head = h; } else if (h < 12) { type = 1; head = h - 8; } else if (h < 16) { type = 2; head = h - 12; }
      else if (h < 24) { type = 3; head = h - 16; } else if (h < 32) { type = 4; head = h - 24; } else { type = 5; head = h - 32; }
      const bool isA = type < 3;
      if (type <= 1) {
        float ss[8];
        _Pragma("unroll") for (int rr = 0; rr < 8; ++rr) ss[rr] = v[rr] * v[rr];
        _Pragma("unroll") for (int o = 32; o >= 1; o >>= 1) { _Pragma("unroll") for (int rr = 0; rr < 8; ++rr) ss[rr] += shx(ss[rr], o, d); }
        const float gg = type == 0 ? gqd : gkd;
        _Pragma("unroll") for (int rr = 0; rr < 8; ++rr) v[rr] = v[rr] * rsqrtf(ss[rr] * (1.f / 64.f) + EPS) * gg;
        if (lat) { _Pragma("unroll") for (int rr = 0; rr < 8; ++rr) { const float other = shx(v[rr], 16, d); v[rr] = ((d & 16) == 0) ? (v[rr] * cs[rr] - other * sn[rr]) : (v[rr] * cs[rr] + other * sn[rr]); } }
      }
      if (type == 0 || type == 3) { bf16_t* qp = Q + (size_t)row0 * D + (type == 0 ? 0 : 512) + head * 64 + d;
        _Pragma("unroll") for (int rr = 0; rr < 8; ++rr) qp[(size_t)rr * D] = f2bf(v[rr]); }
      else if (type == 1 || type == 4) {
        bf16_t* kp = (isA ? KA : KB) + ((size_t)head * KSLOTS + kbase + t0) * 64 + d;
        _Pragma("unroll") for (int rr = 0; rr < 8; ++rr) kp[rr * 64] = f2bf(v[rr]);
        if (!lat) { float* op = isA ? (oak + (size_t)b * (2 * 256 * 256) + (size_t)t0 * 256 + head * 64 + d) : (obk + (size_t)b * (2 * 256 * 512) + (size_t)t0 * 512 + head * 64 + d);
          const int st = isA ? 256 : 512; _Pragma("unroll") for (int rr = 0; rr < 8; ++rr) op[rr * st] = v[rr]; }
      } else {
        const int vh = isA ? head : 4 + head;
        u32x4 pk; pk.x = pk2(v[0], v[1]); pk.y = pk2(v[2], v[3]); pk.z = pk2(v[4], v[5]); pk.w = pk2(v[6], v[7]);
        *(u32x4*)(smem + ((vh * 64 + d) * 72 + w * 8) * 2) = pk;
        if (!lat) { float* op = isA ? (oav + (size_t)b * (2 * 256 * 256) + (size_t)t0 * 256 + head * 64 + d) : (obv + (size_t)b * (2 * 256 * 512) + (size_t)t0 * 512 + head * 64 + d);
          const int st = isA ? 256 : 512; _Pragma("unroll") for (int rr = 0; rr < 8; ++rr) op[rr * st] = v[rr]; }
      }
    }
    __syncthreads();
    for (int vh = 0; vh < 12; ++vh) { const int dd = w * 8 + (d >> 3), seg = d & 7;
      const u32x4 val = *(const u32x4*)(smem + ((vh * 64 + dd) * 72 + seg * 8) * 2);
      bf16_t* vt = (vh < 4 ? VTA + ((size_t)vh * KSLOTS + kbase) * 64 : VTB + ((size_t)(vh - 4) * KSLOTS + kbase) * 64);
      *(u32x4*)(vt + (size_t)dd * Tk + tg0 + seg * 8) = val; }
    __syncthreads();
  }
}

struct ConvItem { f32x4 a[4], b[4]; bf16_t* dst; int K, n0, k0; };
DI void conv_load(const Params& p, int item, ConvItem& ci, int wv) {
  const float* src; int ld, nsrc, K, mode = 1, mi0 = 0; bf16_t* dst; int it;
  char* W = p.ws + WS_W;
  if (item < 2816) { int mi = item / 352; it = item % 352; mode = 0; src = nullptr; ld = DFF; nsrc = 5632; K = 1024; dst = (bf16_t*)(W + W_UP + mi * W_UP_STRIDE); mi0 = mi; }
  else if (item < 4224) { int q = item - 2816; int mi = q / 176; it = q % 176; src = p.w_ffn_down + (size_t)mi * DFF * D; ld = D; nsrc = D; K = DFF; dst = (bf16_t*)(W + W_DOWN + mi * W_DOWN_STRIDE); }
  else if (item < 4544) { int q = item - 4224; int mi = q / 160; it = q % 160; src = p.w_attn_in + (size_t)mi * D * 2560; ld = 2560; nsrc = 2560; K = D; mode = 2; dst = (bf16_t*)(W + W_AIN + mi * W_AIN_STRIDE); }
  else if (item < 4672) { int q = item - 4544; int mi = q / 64; it = q % 64; src = p.w_attn_out + (size_t)mi * D * D; ld = D; nsrc = D; K = D; dst = (bf16_t*)(W + W_AOUT + mi * W_OUT_STRIDE); }
  else if (item < 5088) { int q = item - 4672; int mi = q / 208; it = q % 208; src = p.w_gla_in + (size_t)mi * D * 3104; ld = 3104; nsrc = 3104; K = D; mode = 2; dst = (bf16_t*)(W + W_GIN + mi * W_GIN_STRIDE); }
  else { int q = item - 5088; int mi = q / 64; it = q % 64; src = p.w_gla_out + (size_t)mi * D * D; ld = D; nsrc = D; K = D; dst = (bf16_t*)(W + W_GOUT + mi * W_OUT_STRIDE); }
  const int nkb = K / 256; const int nb = it / nkb, kb = it % nkb; const int n0 = nb * 64, k0 = kb * 256;
  const int tid = opaque_tid(wv);
  { const int kk = tid >> 3, part = tid & 7; const int np = n0 + part * 8;
    const int within = np & 255; const int L = (np & ~255) + ((within >> 5) & 3) * 64 + (within >> 7) * 32 + (within & 31);
    const float* s0 = nullptr; size_t rstride = 0; int second = 4;
    if (mode == 0) { const int h_ = within >> 7, wc_ = (within >> 5) & 3, isup = (within >> 4) & 1, fq0 = (within & 15) >> 2;
      const int f = (((np & ~255) >> 6) + wc_) * 32 + 8 * fq0 + 4 * h_; second = 8;
      s0 = (isup ? p.w_ffn_up : p.w_ffn_gate) + (size_t)mi0 * D * DFF + (size_t)(k0 + kk) * DFF + f; rstride = (size_t)64 * DFF; }
    else if (mode == 2) { const int h_ = within >> 7, wc_ = (within >> 5) & 3, n_ = (within >> 4) & 1, fq0 = (within & 15) >> 2;
      const int c0 = (((np & ~255) >> 6) + wc_) * 64 + 32 * h_ + 8 * fq0 + 4 * n_; second = 8;
      if (c0 < nsrc) { s0 = src + (size_t)(k0 + kk) * ld + c0; rstride = (size_t)64 * ld; } }
    else if (L < nsrc) { s0 = src + (size_t)(k0 + kk) * ld + L; rstride = (size_t)64 * ld; }
    _Pragma("unroll") for (int q = 0; q < 4; ++q) { if (s0) { ci.a[q] = *(const f32x4*)(s0 + q * rstride); ci.b[q] = *(const f32x4*)(s0 + q * rstride + second); } else { ci.a[q] = (f32x4){0.f, 0.f, 0.f, 0.f}; ci.b[q] = ci.a[q]; } }
    ci.dst = dst; ci.K = K; ci.n0 = n0; ci.k0 = k0; }
}

DI void conv_finish(const ConvItem& ci, char* smem, int wv) {
  bf16_t* tile = (bf16_t*)smem;
  const int tid = opaque_tid(wv);
  { const int kk = tid >> 3, part = tid & 7;
    _Pragma("unroll") for (int q = 0; q < 4; ++q) { bf16_t* tp = tile + q * (64 * 72) + (part * 8) * 72 + kk;
      tp[0] = f2bf(ci.a[q][0]); tp[72] = f2bf(ci.a[q][1]); tp[144] = f2bf(ci.a[q][2]); tp[216] = f2bf(ci.a[q][3]); tp[288] = f2bf(ci.b[q][0]); tp[360] = f2bf(ci.b[q][1]); tp[432] = f2bf(ci.b[q][2]); tp[504] = f2bf(ci.b[q][3]); } }
  __syncthreads();
  { const int rr = tid >> 3, ks = tid & 7;
    _Pragma("unroll") for (int q = 0; q < 4; ++q) { u32x4 v = *(const u32x4*)(tile + q * (64 * 72) + rr * 72 + ks * 8); *(u32x4*)(ci.dst + (size_t)(ci.n0 + rr) * ci.K + ci.k0 + q * 64 + ks * 8) = v; } }
  __syncthreads();
}

DI void prep_phase(const Params& p, int wv) {
  extern __shared__ __attribute__((aligned(16))) char smem[];
  const int tid = opaque_tid(wv), G = gridDim.x;
  { f32x4* X = (f32x4*)(p.ws + WS_X); const f32x4* a = (const f32x4*)p.x_prompt; const f32x4* b = (const f32x4*)p.x_sample; const long half = (long)NP * D / 4;
    for (long i = (long)blockIdx.x * 512 + tid; i < 2 * half; i += (long)G * 512) X[i] = i < half ? a[i] : b[i - half]; }
  { float* sc = (float*)smem;
    float* red = sc + 9 * 1024;
    for (int i = tid; i < 9 * 1024; i += 512) { const int c = i >> 10, k = i & 1023; const float v = c == 0 ? p.c_ctx[k] : p.c[(c - 1) * D + k]; sc[i] = silu_f(v); }
    __syncthreads();
    float* MOD = (float*)(p.ws + WS_MOD);
    const int w = tid >> 6, lane = tid & 63;
    for (int it = blockIdx.x; it < 4 * 144; it += G) {
      const int l = it / 144, cgp = it % 144; const int col = cgp * 64 + lane;
      const float* wp = p.w_mod + ((size_t)l * D + w * 128) * (NMOD * D) + col;
      float a[9]; for (int c = 0; c < 9; ++c) a[c] = 0.f;
      for (int k0 = 0; k0 < 128; k0 += 32) { float wgt[32];
        _Pragma("unroll") for (int k = 0; k < 32; ++k) wgt[k] = wp[(size_t)(k0 + k) * (NMOD * D)];
        _Pragma("unroll") for (int k = 0; k < 32; ++k) { _Pragma("unroll") for (int c = 0; c < 9; ++c) a[c] += sc[c * 1024 + w * 128 + k0 + k] * wgt[k]; } }
      for (int c = 0; c < 9; ++c) red[(w * 9 + c) * 64 + lane] = a[c];
      __syncthreads();
      for (int i = tid; i < 576; i += 512) { const int c = i >> 6, ln = i & 63; float s = 0.f; for (int ww = 0; ww < 8; ++ww) s += red[(ww * 9 + c) * 64 + ln];
        const int slot_ = (cgp * 64 + ln) >> 10;
        const float mv = (s + p.b_mod[(size_t)l * (NMOD * D) + cgp * 64 + ln]) * ((slot_ == 2 || slot_ == 8) ? 0.5f : 1.f);
        MOD[((size_t)l * 9 + c) * (NMOD * D) + cgp * 64 + ln] = mv;
        const int jj = cgp * 64 + ln, slot = jj >> 10, kk2 = jj & 1023;
        if (slot == 0 || slot == 3 || slot == 6) { const int inst = slot == 0 ? l * 2 : (slot == 6 ? l * 2 + 1 : ((l & 1) ? 10 + (l >> 1) : 8 + (l >> 1)));
          ((bf16_t*)(p.ws + WS_SH))[(size_t)(inst * 9 + c) * 1024 + kk2] = f2bf(mv); } }
      __syncthreads();
    }
  }
  { u32x4* z = (u32x4*)(p.ws + WS_SH + 108 * 2048); const u32x4 zz = {0u, 0u, 0u, 0u}; for (int i = blockIdx.x * 512 + tid; i < 148 * 128; i += G * 512) z[i] = zz; }
  { ConvItem c0, c1; int item = blockIdx.x;
    if (item < 5216) conv_load(p, item, c0, wv);
    while (item < 5216) {
      if (item + G < 5216) conv_load(p, item + G, c1, wv);
      conv_finish(c0, smem, wv);
      item += G; if (item >= 5216) break;
      if (item + G < 5216) conv_load(p, item + G, c0, wv);
      conv_finish(c1, smem, wv);
      item += G;
    } }
}

DI void norm_phase(const Params& p, const float* g, const float* modp, bool final_, int wv) {
  const float* X = (const float*)(p.ws + WS_X); bf16_t* H = (bf16_t*)(p.ws + WS_H);
  const int tidn = opaque_tid(wv); const int w = tidn >> 6, lane = tidn & 63;
  for (int row = blockIdx.x * 8 + w; row < NTOK; row += gridDim.x * 8) {
    const float* xp = X + (size_t)row * D;
    f32x4 v[4]; float ss = 0.f;
    for (int i = 0; i < 4; ++i) { v[i] = *(const f32x4*)(xp + 4 * (lane + 64 * i)); ss += v[i][0] * v[i][0] + v[i][1] * v[i][1] + v[i][2] * v[i][2] + v[i][3] * v[i][3]; }
    for (int o = 32; o >= 1; o >>= 1) ss += shx(ss, o, lane);
    const float rstd = rsqrtf(ss * (1.f / 1024.f) + EPS);
    if (final_) {
      for (int i = 0; i < 4; ++i) { const int col = 4 * (lane + 64 * i); f32x4 gg = *(const f32x4*)(g + col); *(f32x4*)(p.out + (size_t)row * D + col) = v[i] * rstd * gg; }
    } else {
      const float* mp = modp + (size_t)cond_of_row(row) * (NMOD * D);
      for (int i = 0; i < 4; ++i) { const int col = 4 * (lane + 64 * i); f32x4 gg = *(const f32x4*)(g + col), sh = *(const f32x4*)(mp + col), scl = *(const f32x4*)(mp + D + col);
        f32x4 h = v[i] * rstd * gg * (scl + 1.f) + sh; u32x2 o; o.x = pk2(h[0], h[1]); o.y = pk2(h[2], h[3]); *(u32x2*)(H + (size_t)row * D + col) = o; }
    }
  }
}

DI void cache_phase(const Params& p, int i, int wv) {
  bf16_t* KA = (bf16_t*)(p.ws + WS_KA); bf16_t* VTA = (bf16_t*)(p.ws + WS_VTA); bf16_t* KB = (bf16_t*)(p.ws + WS_KB); bf16_t* VTB = (bf16_t*)(p.ws + WS_VTB);
  const long nA = 8L * 512 * 256, nB = 8L * 512 * 512;
  const int tidc = opaque_tid(wv);
  for (long e = (long)blockIdx.x * 512 + tidc; e < nA + nB; e += (long)gridDim.x * 512) {
    if (e < nA) { const int d = e & 63, hd = (e >> 6) & 3, t = (e >> 8) & 511, b = (int)(e >> 17);
      const size_t si = ((((size_t)b * 2 + i) * 512 + t) * 4 + hd) * 64 + d; const size_t kb = (size_t)hd * KSLOTS + NP + b * 1536;
      KA[(kb + 1024 + t) * 64 + d] = f2bf(p.cache_a_k[si]); }
    else { const long q = e - nA; const int d = q & 63, hd = (q >> 6) & 7, t = (q >> 9) & 511, b = (int)(q >> 18);
      const size_t si = ((((size_t)b * 2 + i) * 512 + t) * 8 + hd) * 64 + d; const size_t kb = (size_t)hd * KSLOTS + NP + b * 1536;
      KB[(kb + 1024 + t) * 64 + d] = f2bf(p.cache_b_k[si]); }
  }
  const long uA = 8L * 4 * 64 * 64, uB = 8L * 8 * 64 * 64;
  for (long u = (long)blockIdx.x * 512 + tidc; u < uA + uB; u += (long)gridDim.x * 512) {
    const bool isA = u < uA; const long q = isA ? u : u - uA; const int nh = isA ? 4 : 8;
    const int d = q & 63; const int t8 = (q >> 6) & 63; const int hd = (int)((q >> 12) % nh); const int b = (int)((q >> 12) / nh);
    const float* src = (isA ? p.cache_a_v : p.cache_b_v) + ((((size_t)b * 2 + i) * 512 + t8 * 8) * nh + hd) * 64 + d;
    float v[8];
    _Pragma("unroll") for (int k = 0; k < 8; ++k) v[k] = src[(size_t)k * nh * 64];
    u32x4 pk; pk.x = pk2(v[0], v[1]); pk.y = pk2(v[2], v[3]); pk.z = pk2(v[4], v[5]); pk.w = pk2(v[6], v[7]);
    bf16_t* vt = (isA ? VTA : VTB) + ((size_t)hd * KSLOTS + NP + b * 1536) * 64 + (size_t)d * 1536 + 1024 + t8 * 8;
    *(u32x4*)vt = pk;
  }
}

struct AttnState { f32x16 O0, O1; float m, l; };
struct KVFrag { bf16x8 k[4]; s16x4 v[8]; };
DI void attn_compute(AttnState& st, const bf16x8 (&Qf)[4], const KVFrag& f, int r, int hh, bool na, int kc0, int qc, const float* brow_) {
  f32x16 S = zero16();
  _Pragma("unroll") for (int s = 0; s < 4; ++s) S = MFMA32(f.k[s], Qf[s], S);
  const float sc = 0.125f * 1.4426950408889634f;
  if (na) {
    const int ws = min(max(qc - 8, 0), 48);
    _Pragma("unroll") for (int i = 0; i < 16; ++i) { const int kc = kc0 + crow(i, hh); const bool ok = (kc >= ws) && (kc < ws + 16);
      const float bias = brow_[ok ? (kc - qc + 15) : 15];
      S[i] = ok ? (S[i] * sc + bias * 1.4426950408889634f) : -INFINITY; }
  } else { _Pragma("unroll") for (int i = 0; i < 16; ++i) S[i] *= sc; }
  float mx = S[0]; _Pragma("unroll") for (int i = 1; i < 16; ++i) mx = fmaxf(mx, S[i]);
  mx = fmaxf(mx, shx(mx, 32, r + 32 * hh));
  const float mn = fmaxf(st.m, mx);
  const float alpha = __builtin_amdgcn_exp2f(st.m - mn);
  float rs = 0.f;
  _Pragma("unroll") for (int i = 0; i < 16; ++i) { S[i] = __builtin_amdgcn_exp2f(S[i] - mn); rs += S[i]; }
  rs += shx(rs, 32, r + 32 * hh);
  st.l = st.l * alpha + rs; st.m = mn;
  _Pragma("unroll") for (int i = 0; i < 16; ++i) { st.O0[i] *= alpha; st.O1[i] *= alpha; }
  const bf16x8 P0 = pack_lo(S), P1 = pack_hi(S);
  st.O0 = MFMA32(join4(f.v[0], f.v[1]), P0, st.O0); st.O0 = MFMA32(join4(f.v[2], f.v[3]), P1, st.O0);
  st.O1 = MFMA32(join4(f.v[4], f.v[5]), P0, st.O1); st.O1 = MFMA32(join4(f.v[6], f.v[7]), P1, st.O1);
}

constexpr int AT_K = 0, AT_V = 9216, AT_BUF = 18432;
DI void lds_kv(KVFrag& f, const char* buf, int sb, int r, int hh) {
  const char* kp = buf + AT_K + (32 * sb + r) * 144 + 16 * hh;
  _Pragma("unroll") for (int s = 0; s < 4; ++s) f.k[s] = *(const bf16x8*)(kp + 32 * s);
  const char* v0 = buf + AT_V + r * 144 + 64 * sb + 8 * hh; const char* v1 = v0 + 32 * 144;
  _Pragma("unroll") for (int q = 0; q < 4; ++q) { f.v[q] = *(const s16x4*)(v0 + 16 * q); f.v[4 + q] = *(const s16x4*)(v1 + 16 * q); }
}
DI void attn_phase(const Params& p, int ia, int wv) {
  extern __shared__ __attribute__((aligned(16))) char smem[];
  const bf16_t* Q = (const bf16_t*)(p.ws + WS_Q); const bf16_t* KA = (const bf16_t*)(p.ws + WS_KA); const bf16_t* VTA = (const bf16_t*)(p.ws + WS_VTA);
  const bf16_t* KB = (const bf16_t*)(p.ws + WS_KB); const bf16_t* VTB = (const bf16_t*)(p.ws + WS_VTB); bf16_t* O = (bf16_t*)(p.ws + WS_O);
  const int tida = opaque_tid(wv); const int w = tida >> 6, lane = tida & 63, r = lane & 31, hh = lane >> 5;
  const int l_row = tida >> 3, l_pc = tida & 7; const int l_dst = l_row * 144 + l_pc * 16;
  for (int item0 = blockIdx.x; item0 < 1024; item0 += gridDim.x) {
    const int item = (item0 & ~255) | ((item0 & 7) << 5) | ((item0 & 255) >> 3);
    int qrow0, qcol, Tk, nstep_plain, plain0, mode; const bf16_t *Kb, *Vb; int b = 0, head = 0, qr = 0, c0 = 0, R0 = 0, nrows = 0;
    if (item < 256) { b = item >> 5; head = (item >> 2) & 7; const int qb = item & 3; mode = 0;
      qrow0 = NP + b * 1024 + qb * 256 + w * 32; qcol = head * 64; Tk = 1536; const size_t kb = (size_t)(head >> 1) * KSLOTS + NP + b * 1536;
      Kb = KA + kb * 64; Vb = VTA + kb * 64; nstep_plain = 24; plain0 = 0; }
    else if (item < 512) { const int q = item - 256; b = q >> 5; head = (q >> 2) & 7; const int rg = q & 3; mode = 1;
      qr = rg * 4 + (w >> 1); c0 = (w & 1) * 32; qrow0 = NP + b * 1024 + qr * 64 + c0; qcol = 512 + head * 64; Tk = 1536; const size_t kb = (size_t)head * KSLOTS + NP + b * 1536;
      Kb = KB + kb * 64; Vb = VTB + kb * 64; nstep_plain = 8; plain0 = 1024;
      R0 = min(max(rg * 4 - 4, 0), 8); nrows = min(max(rg * 4 + 3 - 4, 0), 8) + 8 - R0; }
    else { const int q = item - 512; b = q >> 4; const int mixer = (q >> 3) & 1; head = q & 7; mode = 2;
      qrow0 = b * 256 + w * 32; qcol = mixer * 512 + head * 64; Tk = 256; const size_t kb = (size_t)(mixer ? head : (head >> 1)) * KSLOTS + b * 256;
      Kb = (mixer ? KB : KA) + kb * 64; Vb = (mixer ? VTB : VTA) + kb * 64; nstep_plain = 4; plain0 = 0; }
    bf16x8 Qf[4];
    for (int s = 0; s < 4; ++s) Qf[s] = *(const bf16x8*)(Q + (size_t)(qrow0 + r) * D + qcol + 16 * s + 8 * hh);
    AttnState st; st.O0 = zero16(); st.O1 = zero16(); st.m = -1e30f; st.l = 0.f;
    const int rs0 = min(max(qr - 4, 0), 8); const float* rb = p.na_rel_bias + ((size_t)ia * 8 + head) * 15 * 31;
    const int ntot = nstep_plain + (mode == 1 ? nrows : 0);
#define SK0(idx) ((idx) < nstep_plain ? plain0 + 64 * (idx) : (R0 + (idx) - nstep_plain) * 64)
#define GK(k0_) (*(const u32x4*)(Kb + (size_t)((k0_) + l_row) * 64 + l_pc * 8))
#define GV(k0_) (*(const u32x4*)(Vb + (size_t)l_row * Tk + (k0_) + l_pc * 8))
    u32x4 sk0 = GK(SK0(0)), sv0 = GV(SK0(0)), sk1 = GK(SK0(1)), sv1 = GV(SK0(1));
    for (int idx = 0; idx < ntot; idx += 2) {
      _Pragma("unroll") for (int par = 0; par < 2; ++par) {
        const int ii = idx + par;
        if (ii < ntot) {
          char* buf = smem + par * AT_BUF;
          *(u32x4*)(buf + AT_K + l_dst) = par ? sk1 : sk0; *(u32x4*)(buf + AT_V + l_dst) = par ? sv1 : sv0;
          __syncthreads();
          if (ii + 2 < ntot) { const int kn = SK0(ii + 2); if (par) { sk1 = GK(kn); sv1 = GV(kn); } else { sk0 = GK(kn); sv0 = GV(kn); } }
          const bool na_ = ii >= nstep_plain; const int kr = R0 + ii - nstep_plain;
          if (!na_ || (kr >= rs0 && kr < rs0 + 8)) {
            _Pragma("unroll") for (int sb = 0; sb < 2; ++sb) { KVFrag f; lds_kv(f, buf, sb, r, hh);
              attn_compute(st, Qf, f, r, hh, na_, 32 * sb, c0 + r, rb + (kr - qr + 7) * 31); }
          }
        }
      }
    }
    __syncthreads();
#undef SK0
#undef GK
#undef GV
    const float inv = 1.f / st.l;
    bf16_t* op = O + (size_t)(qrow0 + r) * D + qcol;
    for (int g4 = 0; g4 < 4; ++g4) { const int d0 = 8 * g4 + 4 * hh;
      u32x2 a; a.x = pk2(st.O0[4 * g4] * inv, st.O0[4 * g4 + 1] * inv); a.y = pk2(st.O0[4 * g4 + 2] * inv, st.O0[4 * g4 + 3] * inv); *(u32x2*)(op + d0) = a;
      u32x2 c; c.x = pk2(st.O1[4 * g4] * inv, st.O1[4 * g4 + 1] * inv); c.y = pk2(st.O1[4 * g4 + 2] * inv, st.O1[4 * g4 + 3] * inv); *(u32x2*)(op + 32 + d0) = c; }
  }
}

constexpr int G_QIN = 0, G_KIN = 17408, G_KOT = 34816, G_VT = 53248, G_TOT = 90112, G_DEC = 92160, G_DL = 92672;
DI void gla_item(const Params& p, int j, int rowbase, int T, int bout, int bstate, int hd, int dir, char* smem, int wv) {
  const bf16_t* GB = (const bf16_t*)(p.ws + WS_BIG + BIG_GLABUF); const float* DG = (const float*)(p.ws + WS_BIG + BIG_DG);
  bf16_t* OX = (bf16_t*)(p.ws + WS_BIG + (dir ? BIG_OB : BIG_OF));
  const int tid = opaque_tid(wv), w = tid >> 6, lane = tid & 63, r = lane & 31, hh = lane >> 5;
  const int dk = tid & 127, pg = tid >> 7;
  float* TOT = (float*)(smem + G_TOT); float* DEC = (float*)(smem + G_DEC); float* DL = (float*)(smem + G_DL);
  float wcol[16]; const float* wg = p.w_gla_gup + (((size_t)j * 2 + dir) * 16) * 512 + hd * 128 + dk;
  for (int q = 0; q < 16; ++q) wcol[q] = wg[q * 512];
  const float bcol_ = p.b_gla_gup[((size_t)j * 2 + dir) * 512 + hd * 128 + dk];
  f32x16 S[4];
  if (bstate >= 0) { const float* sp = p.state_gla + ((((size_t)bstate * 2 + j) * 2 + dir) * 4 + hd) * 128 * 256 + 32 * w + r;
    for (int blk = 0; blk < 4; ++blk) for (int i = 0; i < 16; ++i) S[blk][i] = sp[(size_t)(32 * blk + crow(i, hh)) * 256]; }
  else { for (int blk = 0; blk < 4; ++blk) S[blk] = zero16(); }
  const int nchunk = T / 64;
  for (int ci = 0; ci < nchunk; ++ci) {
#define ROWOF(pp) (rowbase + (dir ? (T - 1 - (ci * 64 + (pp))) : (ci * 64 + (pp))))
    if (tid < 256) { const int pp = tid >> 2, qq = tid & 3; *(f32x4*)(DL + pp * 16 + qq * 4) = *(const f32x4*)(DG + (size_t)ROWOF(pp) * 32 + dir * 16 + qq * 4); }
    __syncthreads();
    float bl[16]; { float run = 0.f;
      _Pragma("unroll") for (int e = 0; e < 16; e += 2) { const float* dl = DL + (pg * 16 + e) * 16; f32x2 z2 = {bcol_, bcol_};
        _Pragma("unroll") for (int q4 = 0; q4 < 4; ++q4) { const f32x4 d0 = *(const f32x4*)(dl + 4 * q4), d1 = *(const f32x4*)(dl + 16 + 4 * q4);
          _Pragma("unroll") for (int q = 0; q < 4; ++q) { const f32x2 dd = {d0[q], d1[q]}; z2 += dd * wcol[4 * q4 + q]; } }
        _Pragma("unroll") for (int u = 0; u < 2; ++u) { const float z = z2[u]; const float ls = fminf(z, 0.f) - __logf(1.f + __expf(-fabsf(z))); run += ls * (1.f / 16.f); bl[e + u] = run; } }
      TOT[pg * 128 + dk] = run; }
    __syncthreads();
    { float off = 0.f, blast = 0.f; for (int g = 0; g < 4; ++g) { const float tv = TOT[g * 128 + dk]; blast += tv; if (g < pg) off += tv; }
      const float eblast = __expf(blast);
      if (pg == 0) DEC[dk] = eblast;
      unsigned ko[8];
      for (int e = 0; e < 16; e += 2) { float kv[2];
        for (int u = 0; u < 2; ++u) { const int pp = pg * 16 + e + u; const size_t rb = (size_t)ROWOF(pp) * 3072 + hd * 128 + dk; const float bb = bl[e + u] + off;
          const float qv = bf2f(GB[rb]) * 0.08838834764831845f, kk = bf2f(GB[rb + 512]);
          const float eb = __expf(bb), kin = kk * __builtin_amdgcn_rcpf(eb);
          *(bf16_t*)(smem + G_QIN + pp * 272 + dk * 2) = f2bf(qv * eb); *(bf16_t*)(smem + G_KIN + pp * 272 + dk * 2) = f2bf(kin); kv[u] = kin * eblast; }
        ko[e >> 1] = pk2(kv[0], kv[1]); }
      u32x4 k0; k0.x = ko[0]; k0.y = ko[1]; k0.z = ko[2]; k0.w = ko[3]; u32x4 k1; k1.x = ko[4]; k1.y = ko[5]; k1.z = ko[6]; k1.w = ko[7];
      *(u32x4*)(smem + G_KOT + dk * 144 + pg * 32) = k0; *(u32x4*)(smem + G_KOT + dk * 144 + pg * 32 + 16) = k1; }
    { const int dv = tid & 255, hf = tid >> 8;
      for (int e8 = 0; e8 < 4; ++e8) { float vv[8];
        for (int u = 0; u < 8; ++u) { const int pp = hf * 32 + e8 * 8 + u; vv[u] = bf2f(GB[(size_t)ROWOF(pp) * 3072 + 1024 + hd * 256 + dv]); }
        u32x4 o; o.x = pk2(vv[0], vv[1]); o.y = pk2(vv[2], vv[3]); o.z = pk2(vv[4], vv[5]); o.w = pk2(vv[6], vv[7]);
        *(u32x4*)(smem + G_VT + dv * 144 + hf * 64 + e8 * 16) = o; } }
    __syncthreads();
    bf16x8 Sp[4][2];
    for (int blk = 0; blk < 4; ++blk) { Sp[blk][0] = pack_lo(S[blk]); Sp[blk][1] = pack_hi(S[blk]); }
    f32x16 aT[3];
    for (int ti = 0; ti < 3; ++ti) { const int kt = ti == 2 ? 1 : 0, qt = ti == 0 ? 0 : 1; f32x16 a = zero16();
      for (int s = 0; s < 8; ++s) { bf16x8 A = *(const bf16x8*)(smem + G_KIN + (32 * kt + r) * 272 + (16 * s + 8 * hh) * 2); bf16x8 B = *(const bf16x8*)(smem + G_QIN + (32 * qt + r) * 272 + (16 * s + 8 * hh) * 2); a = MFMA32(A, B, a); }
      if (kt == qt) for (int i = 0; i < 16; ++i) a[i] = (crow(i, hh) <= r) ? a[i] : 0.f;
      aT[ti] = a; }
    const char* vrow = smem + G_VT + (32 * w + r) * 144;
    for (int qt = 0; qt < 2; ++qt) { f32x16 o = zero16();
      for (int kt = 0; kt <= qt; ++kt) { const f32x16& a = (qt == 0) ? aT[0] : (kt == 0 ? aT[1] : aT[2]);
        bf16x8 A0 = pack_lo(a), A1 = pack_hi(a);
        bf16x8 B0 = join4(*(const s16x4*)(vrow + (32 * kt + 4 * hh) * 2), *(const s16x4*)(vrow + (32 * kt + 8 + 4 * hh) * 2));
        bf16x8 B1 = join4(*(const s16x4*)(vrow + (32 * kt + 16 + 4 * hh) * 2), *(const s16x4*)(vrow + (32 * kt + 24 + 4 * hh) * 2));
        o = MFMA32(A0, B0, o); o = MFMA32(A1, B1, o); }
      const char* qrow_ = smem + G_QIN + (32 * qt + r) * 272;
      for (int blk = 0; blk < 4; ++blk) for (int s = 0; s < 2; ++s) {
        bf16x8 A2 = join4(*(const s16x4*)(qrow_ + (32 * blk + 16 * s + 4 * hh) * 2), *(const s16x4*)(qrow_ + (32 * blk + 16 * s + 8 + 4 * hh) * 2));
        o = MFMA32(A2, Sp[blk][s], o); }
      for (int i = 0; i < 16; ++i) { const int pp = 32 * qt + crow(i, hh); OX[(size_t)ROWOF(pp) * D + hd * 256 + 32 * w + r] = f2bf(o[i]); } }
    for (int blk = 0; blk < 4; ++blk) { f32x16 s_ = S[blk];
      for (int i = 0; i < 16; ++i) s_[i] *= DEC[32 * blk + crow(i, hh)];
      for (int s = 0; s < 4; ++s) { bf16x8 A = *(const bf16x8*)(smem + G_KOT + (32 * blk + r) * 144 + (16 * s + 8 * hh) * 2); bf16x8 B = *(const bf16x8*)(vrow + (16 * s + 8 * hh) * 2); s_ = MFMA32(A, B, s_); }
      S[blk] = s_; }
    __syncthreads();
#undef ROWOF
  }
  if (bout >= 0) { float* op = p.out + OFF_GLA + ((((size_t)bout * 2 + j) * 2 + dir) * 4 + hd) * 128 * 256 + 32 * w + r;
    for (int blk = 0; blk < 4; ++blk) for (int i = 0; i < 16; ++i) op[(size_t)(32 * blk + crow(i, hh)) * 256] = S[blk][i]; }
}
DI void gla_phase(const Params& p, int j, int wv) {
  extern __shared__ __attribute__((aligned(16))) char smem[];
  const int G = gridDim.x, bid = blockIdx.x;
  if (G > 64) {
    if (bid < 64) { const int b = bid >> 3, hd = (bid >> 1) & 3, dir = bid & 1; gla_item(p, j, NP + b * 1024, 1024, -1, b, hd, dir, smem, wv); }
    else for (int it = bid - 64; it < 256; it += G - 64) { const int b = it >> 3, hd = (it >> 1) & 3, dir = it & 1; gla_item(p, j, b * 256, 256, b, -1, hd, dir, smem, wv); }
  } else {
    for (int it = bid; it < 320; it += G) {
      if (it < 64) { const int b = it >> 3, hd = (it >> 1) & 3, dir = it & 1; gla_item(p, j, NP + b * 1024, 1024, -1, b, hd, dir, smem, wv); }
      else { const int q = it - 64; const int b = q >> 3, hd = (q >> 1) & 3, dir = q & 1; gla_item(p, j, b * 256, 256, b, -1, hd, dir, smem, wv); } }
  }
}
DI void gla_post_phase(const Params& p, int j, int wv) {
  const bf16_t* GB = (const bf16_t*)(p.ws + WS_BIG + BIG_GLABUF); const bf16_t* OF = (const bf16_t*)(p.ws + WS_BIG + BIG_OF); const bf16_t* OB = (const bf16_t*)(p.ws + WS_BIG + BIG_OB);
  bf16_t* O = (bf16_t*)(p.ws + WS_O); const float* gn = p.g_gla_norm + j * 256;
  const int tidp = opaque_tid(wv); const int w = tidp >> 6, lane = tidp & 63;
  for (int row = blockIdx.x * 8 + w; row < NTOK; row += gridDim.x * 8) {
    const int col = 16 * lane; float o[16]; float ss = 0.f;
    for (int e = 0; e < 16; ++e) { o[e] = bf2f(OF[(size_t)row * D + col + e]) + bf2f(OB[(size_t)row * D + col + e]); ss += o[e] * o[e]; }
    for (int x = 8; x >= 1; x >>= 1) ss += shx(ss, x, lane);
    const float rstd = rsqrtf(ss * (1.f / 256.f) + EPS);
    unsigned pk[8];
    for (int e = 0; e < 16; e += 2) { float y[2];
      for (int u = 0; u < 2; ++u) { const float g = bf2f(GB[(size_t)row * 3072 + 2048 + col + e + u]); y[u] = o[e + u] * rstd * gn[(col & 255) + e + u] * silu_f(g); }
      pk[e >> 1] = pk2(y[0], y[1]); }
    u32x4 a; a.x = pk[0]; a.y = pk[1]; a.z = pk[2]; a.w = pk[3]; u32x4 b; b.x = pk[4]; b.y = pk[5]; b.z = pk[6]; b.w = pk[7];
    *(u32x4*)(O + (size_t)row * D + col) = a; *(u32x4*)(O + (size_t)row * D + col + 8) = b;
  }
}

DI void init_xg_phase(const Params& p, int wv) {
  const float* X = (const float*)(p.ws + WS_X); bf16_t* XG = (bf16_t*)(p.ws + WS_H); float* RS = (float*)(p.ws + WS_RS);
  const float* g = p.g_norm; const float* MOD = (const float*)(p.ws + WS_MOD);
  const int tidn = opaque_tid(wv); const int w = tidn >> 6, lane = tidn & 63;
  for (int row = blockIdx.x * 8 + w; row < NTOK; row += gridDim.x * 8) {
    const float* xp = X + (size_t)row * D; const float* mp = MOD + (size_t)cond_of_row(row) * (NMOD * D) + D;
    float ss = 0.f;
    for (int i = 0; i < 4; ++i) { const int col = 4 * (lane + 64 * i); const f32x4 v = *(const f32x4*)(xp + col);
      ss += v[0] * v[0] + v[1] * v[1] + v[2] * v[2] + v[3] * v[3];
      const f32x4 h = v * *(const f32x4*)(g + col) * (*(const f32x4*)(mp + col) + 1.f);
      u32x2 o; o.x = pk2(h[0], h[1]); o.y = pk2(h[2], h[3]); *(u32x2*)(XG + (size_t)row * D + col) = o; }
    for (int o = 32; o >= 1; o >>= 1) ss += shx(ss, o, lane);
    if (lane == 0) { f32x4 q = {ss, 0.f, 0.f, 0.f}; *(f32x4*)(RS + (size_t)row * 4) = q; }
  }
}
#define XB_TMO      128
#define XB_XCNT(j)  (256  + 64 * (j))
#define XB_XSUB(j)  (1280 + 64 * (j))
#define XB_XGEN(j)  (2304 + 64 * (j))
#define XB_TOP      3328
#define XB_TOPGEN   3392
#define XCD_BAR_WORDS 3456
#define XB_SPIN_CAP (1u << 20)
DI unsigned xb_ld(unsigned* p) { return __hip_atomic_load(p, __ATOMIC_RELAXED, __HIP_MEMORY_SCOPE_AGENT); }
DI unsigned xb_add(unsigned* p, unsigned v) { return __hip_atomic_fetch_add(p, v, __ATOMIC_RELAXED, __HIP_MEMORY_SCOPE_AGENT); }
DI unsigned xb_xcc_id() { return (unsigned)__builtin_amdgcn_s_getreg((3 << 11) | 20) & 0xFu; }
#define XB_SPIN(cond, bar) do { unsigned _sp = 0; while (cond) { __builtin_amdgcn_s_sleep(1); \
    if ((++_sp & 255u) == 0u) { if (xb_ld(&(bar)[XB_TMO])) break; if (_sp > XB_SPIN_CAP) { atomicAdd(&(bar)[XB_TMO], 1u); break; } } } } while (0)
DI void xcd_barrier_complete(unsigned* bar, unsigned x, unsigned& nloc, unsigned& nx) {
  const unsigned G = gridDim.x;
  unsigned sum, cnt, mine, sp = 0u;
  for (;;) {
    sum = 0u; cnt = 0u; mine = 0u;
    _Pragma("unroll") for (unsigned j = 0; j < 16; ++j) { const unsigned c = xb_ld(&bar[XB_XCNT(j)]); sum += c; cnt += (c > 0u) ? 1u : 0u; mine = (j == x) ? c : mine; }
    if (sum == G) break;
    __builtin_amdgcn_s_sleep(1);
    if ((++sp & 255u) == 0u) { if (xb_ld(&bar[XB_TMO])) break; if (sp > XB_SPIN_CAP) { atomicAdd(&bar[XB_TMO], 1u); break; } }
  }
  nloc = mine > 0u ? mine : 1u; nx = cnt > 0u ? cnt : 1u;
}
DI void grid_bar(unsigned* bar, volatile unsigned* st  , int wv) {
  asm volatile("s_waitcnt vmcnt(0)" ::: "memory");
  __syncthreads();
  const int tid = opaque_tid(wv);
  if (tid == 0) {
    __builtin_amdgcn_s_waitcnt(0);
    const unsigned x = xb_xcc_id();
    unsigned nloc = st[0], nx = st[1];
    if (nloc == 0u) { xcd_barrier_complete(bar, x, nloc, nx); st[0] = nloc; st[1] = nx; }
    const unsigned old = xb_add(&bar[XB_XSUB(x)], 1u);
    const unsigned gen = old / nloc;
    if (old + 1u == (gen + 1u) * nloc) {
      __builtin_amdgcn_fence(__ATOMIC_RELEASE, "agent");
      asm volatile("s_waitcnt vmcnt(0)" ::: "memory");
      const unsigned og = xb_add(&bar[XB_TOP], 1u);
      const unsigned tg = og / nx;
      if (og + 1u == (tg + 1u) * nx) xb_add(&bar[XB_TOPGEN], 1u);
      else XB_SPIN(xb_ld(&bar[XB_TOPGEN]) == tg, bar);
      __builtin_amdgcn_fence(__ATOMIC_ACQUIRE, "agent");
      xb_add(&bar[XB_XGEN(x)], 1u);
      asm volatile("s_waitcnt vmcnt(0)" ::: "memory");
    } else {
      XB_SPIN(xb_ld(&bar[XB_XGEN(x)]) == gen, bar);
      __builtin_amdgcn_fence(__ATOMIC_ACQUIRE, "agent");
      asm volatile("s_waitcnt vmcnt(0)" ::: "memory");
    }
  }
  __syncthreads();
}
__global__ void __launch_bounds__(512, 2) mega(Params p) {
  cg::grid_group grid = cg::this_grid();
  const int wv = __builtin_amdgcn_readfirstlane(threadIdx.x >> 6);
  unsigned* barctr = (unsigned*)(p.ws + WS_BAR);
  __shared__ unsigned xb_words[4];
  if (threadIdx.x < 4) xb_words[threadIdx.x] = 0u;
  if (threadIdx.x == 0) (void)xb_add(&barctr[XB_XCNT(xb_xcc_id())], 1u);
  if (p.ws == nullptr) grid.sync();
  prep_phase(p, wv);
  grid_bar(barctr, xb_words, wv);
  {
    init_xg_phase(p, wv);
    EpiSW e; e.sw = (float*)(p.ws + WS_SW);
    gemm_phase((const bf16_t*)(p.ws + WS_SH), (const bf16_t*)(p.ws + WS_W), 256, NCONS, D, e, wv);
    grid_bar(barctr, xb_words, wv);
  }
  for (int ph = 0; ph < 32; ++ph) {
    const int l = ph >> 3, s = ph & 7;
    char* ws = p.ws; asm volatile("" : "+s"(ws));
    char* W = ws + WS_W;
    const float* modl = (const float*)(ws + WS_MOD) + (size_t)l * 9 * (NMOD * D);
    const float* SW = (const float*)(ws + WS_SW); float* RS = (float*)(ws + WS_RS);
    const bool isattn = (l & 1) == 0; const int li = l >> 1;
    if (s == 0 || s == 6) {
      const int f = s == 0 ? 0 : 1;
      EpiSwiGLU es; es.act = (bf16_t*)(ws + WS_BIG); es.rs = RS + (size_t)(l * 3 + (f ? 2 : 0)) * (NTOK * 4); es.sw = SW + (l * 2 + f) * 5632;
      gemm_phase((const bf16_t*)(ws + WS_H), (const bf16_t*)(W + W_UP + (size_t)(l * 2 + f) * W_UP_STRIDE), NTOK, 5632, D, es, wv);
    } else if (s == 1 || s == 7 || s == 5) {
      const int f = s == 1 ? 0 : 1;
      const bool isout = s == 5;
      const float* gate = modl + (isout ? 5 : (f == 0 ? 2 : 8)) * D;
      const bf16_t* A = (const bf16_t*)(ws + (isout ? WS_O : WS_BIG));
      const int K = isout ? D : DFF;
      const bf16_t* Bt = (const bf16_t*)(isout ? (isattn ? (W + W_AOUT + li * W_OUT_STRIDE) : (W + W_GOUT + li * W_OUT_STRIDE)) : (W + W_DOWN + (size_t)(l * 2 + f) * W_DOWN_STRIDE));
      const int nid = isout ? l * 3 + 2 : (f == 0 ? l * 3 + 1 : (l + 1) * 3);
      const EpiResid er = {ws, gate, p.g_norm, nid};
      gemm_phase(A, Bt, NTOK, D, K, er, wv);
    } else if (s == 2) {
      const float* rsn = RS + (size_t)(l * 3 + 1) * (NTOK * 4);
      if (isattn) {
        cache_phase(p, li, wv);
        EpiPlain e; e.buf = (bf16_t*)(ws + WS_BIG); e.ldc = 2560; e.rs = rsn; e.sw = SW + 45056 + li * 2560;
        gemm_phase((const bf16_t*)(ws + WS_H), (const bf16_t*)(W + W_AIN + li * W_AIN_STRIDE), NTOK, 2560, D, e, wv);
      } else {
        EpiGlaIn e; e.buf = (bf16_t*)(ws + WS_BIG + BIG_GLABUF); e.dg = (float*)(ws + WS_BIG + BIG_DG); e.rs = rsn; e.sw = SW + 50176 + li * 3328;
        gemm_phase((const bf16_t*)(ws + WS_H), (const bf16_t*)(W + W_GIN + li * W_GIN_STRIDE), NTOK, 3328, D, e, wv);
      }
    } else if (s == 3) {
      if (isattn) qkv_post_phase(p, li, wv); else gla_phase(p, li, wv);
    } else {
      if (isattn) attn_phase(p, li, wv); else gla_post_phase(p, li, wv);
    }
    grid_bar(barctr, xb_words, wv);
  }
  norm_phase(p, p.g_final, nullptr, true, wv);
}

extern "C" void kernel_launch(void* const* d_in, const int* in_sizes, int n_in, void* d_out, int out_size, void* d_ws, size_t ws_size, hipStream_t stream) {
  constexpr size_t kDynLds = 131072;
  static int grid_blocks = 0;
  if (!grid_blocks) {
    int dev = 0, cus = 0, per_cu = 0;
    (void)hipGetDevice(&dev);
    (void)hipDeviceGetAttribute(&cus, hipDeviceAttributeMultiprocessorCount, dev);
    (void)hipFuncSetAttribute((const void*)mega, hipFuncAttributeMaxDynamicSharedMemorySize, (int)kDynLds);
    (void)hipOccupancyMaxActiveBlocksPerMultiprocessor(&per_cu, mega, 512, kDynLds);
    if (per_cu < 1) per_cu = 1;
    if (per_cu > 1) per_cu = 1;
    grid_blocks = cus * per_cu;
  }
  Params p{};
  const float** pp = (const float**)&p;
  for (int i = 0; i < 26; ++i) pp[i] = (const float*)d_in[i];
  p.out = (float*)d_out; p.ws = (char*)d_ws;
  (void)hipMemsetAsync((char*)d_ws + WS_BAR, 0, XCD_BAR_WORDS * sizeof(unsigned), stream);
  void* args[] = {&p};
  hipError_t e = hipLaunchCooperativeKernel((void*)mega, dim3(grid_blocks), dim3(512), args, kDynLds, stream);
  if (e != hipSuccess) fprintf(stderr, "cooperative launch failed: %s (grid %d)\n", hipGetErrorString(e), grid_blocks);
}
```

```cpp
#include <hip/hip_runtime.h>
#include <hip/hip_cooperative_groups.h>
#include <cstdio>
#include <cstdint>
namespace cg = cooperative_groups;

typedef unsigned short bf16_t;
typedef short bf16x8 __attribute__((ext_vector_type(8)));
typedef short s16x4 __attribute__((ext_vector_type(4)));
typedef float f32x4 __attribute__((ext_vector_type(4)));
typedef float f32x16 __attribute__((ext_vector_type(16)));
typedef unsigned u32x4 __attribute__((ext_vector_type(4)));
typedef unsigned u32x2 __attribute__((ext_vector_type(2)));
#define DI __device__ __forceinline__

constexpr int D = 1024, NTOK = 16384, NP = 8192, DFF = 2816, NMOD = 9;
constexpr int KSLOTS = 20480;
constexpr float EPS = 1e-6f;
constexpr long OFF_YP = 0, OFF_AK = 16777216, OFF_AV = 20971520, OFF_BK = 25165824, OFF_BV = 33554432, OFF_GLA = 41943040;
constexpr size_t WS_X = 0, WS_H = 67108864, WS_O = 100663296, WS_Q = 134217728, WS_KA = 167772160, WS_VTA = 178257920,
                 WS_KB = 188743680, WS_VTB = 209715200, WS_BIG = 230686720, WS_MOD = 400556032, WS_BAR = 402653184 - 16384, WS_W = 402653184;
constexpr size_t BIG_GLABUF = 0, BIG_OF = 100663296, BIG_OB = 134217728, BIG_DG = 167772160;
constexpr size_t W_UP = 0, W_UP_STRIDE = 11534336, W_AIN = 92274688, W_AIN_STRIDE = 5242880, W_GIN = 102760448, W_GIN_STRIDE = 6815744;
constexpr size_t W_DOWN = 116391936, W_DOWN_STRIDE = 5767168, W_AOUT = 162529280, W_GOUT = 166723584, W_OUT_STRIDE = 2097152;
constexpr int NCONS = 56832;
constexpr size_t WS_SH = WS_W + 170917888, WS_SW = WS_SH + 524288, WS_RS = WS_SW + 2097152;

struct Params {
  const float *x_prompt, *x_sample, *cache_a_k, *cache_a_v, *cache_b_k, *cache_b_v, *state_gla, *c, *c_ctx, *w_mod, *b_mod, *g_norm,
      *w_ffn_gate, *w_ffn_up, *w_ffn_down, *w_attn_in, *w_attn_out, *g_qnorm, *g_knorm, *na_rel_bias, *w_gla_in, *w_gla_gup, *b_gla_gup,
      *g_gla_norm, *w_gla_out, *g_final;
  float* out;
  char* ws;
};

typedef float f32x2 __attribute__((ext_vector_type(2)));
typedef __bf16 nbf16x2 __attribute__((ext_vector_type(2)));
DI unsigned pk2(float lo, float hi) { f32x2 v = {lo, hi}; return __builtin_bit_cast(unsigned, __builtin_convertvector(v, nbf16x2)); }
DI unsigned short f2bf(float x) { return (unsigned short)(pk2(x, x) & 0xffffu); }
DI float bf2f(unsigned short b) { return __uint_as_float(((unsigned)b) << 16); }
DI float silu_f(float x) { return x * __builtin_amdgcn_rcpf(1.f + __builtin_amdgcn_exp2f(-1.4426950408889634f * x)); }
DI int crow(int reg, int hh) { return (reg & 3) + 8 * (reg >> 2) + 4 * hh; }
DI bf16x8 pack8(float a, float b, float c, float d, float e, float f, float g, float h) {
  u32x4 p; p.x = pk2(a, b); p.y = pk2(c, d); p.z = pk2(e, f); p.w = pk2(g, h); return __builtin_bit_cast(bf16x8, p);
}
DI bf16x8 pack_lo(const f32x16& x) { return pack8(x[0], x[1], x[2], x[3], x[4], x[5], x[6], x[7]); }
DI bf16x8 pack_hi(const f32x16& x) { return pack8(x[8], x[9], x[10], x[11], x[12], x[13], x[14], x[15]); }
DI bf16x8 join4(s16x4 lo, s16x4 hi) { return __builtin_shufflevector(lo, hi, 0, 1, 2, 3, 4, 5, 6, 7); }
#define MFMA32(a, b, c) __builtin_amdgcn_mfma_f32_32x32x16_bf16((a), (b), (c), 0, 0, 0)
DI f32x16 zero16() { f32x16 z; for (int i = 0; i < 16; ++i) z[i] = 0.f; return z; }
DI int opaque_tid(int wv) {
  int lane; asm volatile("v_mbcnt_lo_u32_b32 %0, -1, 0\n\tv_mbcnt_hi_u32_b32 %0, -1, %0" : "=v"(lane));
  int w = wv; asm volatile("" : "+s"(w));
  return w * 64 + lane; }
DI float shx(float v, int m, int lane) { return __int_as_float(__builtin_amdgcn_ds_bpermute((lane ^ m) << 2, __float_as_int(v))); }
DI int cond_of_row(int row) { return row < NP ? 0 : 1 + ((row - NP) >> 10); }

constexpr int BM = 256, BK = 64, HALF = 128, NXCD = 8, WGM = 8, HT = HALF * BK;
DI int lds_byte(int r, int c) { int st = (r >> 4) * 2 + (c >> 5), rr = r & 15, cc = c & 31, ob = rr * 64 + cc * 2; return st * 1024 + (ob ^ (((ob >> 9) & 1) << 5)); }
DI void stage_rc(int b, int& R, int& C) { int st = b / 1024, sb = b % 1024, swz = sb ^ (((sb >> 9) & 1) << 5); R = (st >> 1) * 16 + swz / 64; C = (st & 1) * 32 + (swz % 64) / 2; }

DI void glds16(const char* sbase, unsigned voff, unsigned ldsdst) {
  unsigned keep;
  asm volatile("s_mov_b32 %0, m0\n\ts_mov_b32 m0, %3\n\ts_nop 0\n\tglobal_load_lds_dwordx4 %1, %2\n\ts_mov_b32 m0, %0" : "=&s"(keep) : "v"(voff), "s"(sbase), "s"(ldsdst) : "memory");
}
template <class Epi>
__device__ __forceinline__ void gemm_phase(const bf16_t* __restrict__ A, const bf16_t* __restrict__ Bt, int M, int N, int K, const Epi epi, int wv) {
  extern __shared__ __attribute__((aligned(16))) char smem[];
  bf16_t* shm = (bf16_t*)smem;
#define SA(b, h) (shm + ((b) * 2 + (h)) * HT)
#define SB(b, h) (shm + (4 + (b) * 2 + (h)) * HT)
#define STAGE(P, BASE, br, kt) do { const char* _sb = (const char*)(BASE) + ((long)(br) * K + (long)(kt) * BK) * 2; \
      const unsigned _ld = ldsw + (unsigned)((const char*)(P) - (const char*)shm); \
      glds16(_sb, voff0, _ld); glds16(_sb, voff1, _ld + 8192u); } while (0)
#define LDA(dst, b, h) for (int m = 0; m < 4; ++m) for (int k = 0; k < 2; ++k) \
    dst[m][k] = *reinterpret_cast<const bf16x8*>((char*)SA(b, h) + lds_byte(wr * 64 + m * 16 + fr, k * 32 + fq * 8))
#define LDB(dst, b, h) for (int n = 0; n < 2; ++n) for (int k = 0; k < 2; ++k) \
    dst[n][k] = *reinterpret_cast<const bf16x8*>((char*)SB(b, h) + lds_byte(wc * 32 + n * 16 + fr, k * 32 + fq * 8))
#define MMA(ai, bj, Atf, Btf) do { __builtin_amdgcn_s_setprio(1); \
    for (int m = 0; m < 4; ++m) for (int n = 0; n < 2; ++n) for (int k = 0; k < 2; ++k) \
      acc[ai][bj][m][n] = __builtin_amdgcn_mfma_f32_16x16x32_bf16(Btf[n][k], Atf[m][k], acc[ai][bj][m][n], 0, 0, 0); \
    __builtin_amdgcn_s_setprio(0); } while (0)
#define WAIT_V(n) asm volatile("s_waitcnt vmcnt(" #n ")" ::: "memory")
#define WAIT_L(n) asm volatile("s_waitcnt lgkmcnt(" #n ")" ::: "memory")
#define BAR __builtin_amdgcn_s_barrier()
#define SCHED __builtin_amdgcn_sched_barrier(0)
  const int nM = M / BM, nN = N / BM, nwg = nM * nN;
  const int tidg = opaque_tid(wv);
  const int wid = tidg >> 6, lane = tidg & 63, wr = wid >> 2, wc = wid & 3, fr = lane & 15, fq = lane >> 4;
  const int nt = K / BK;
  unsigned voff0, voff1;
  const unsigned ldsw = (unsigned)(size_t)smem + (unsigned)__builtin_amdgcn_readfirstlane(wid) * 1024u;
  { int _r, _c; stage_rc(tidg * 16, _r, _c); voff0 = (unsigned)(_r * K + _c) * 2u; stage_rc(tidg * 16 + 8192, _r, _c); voff1 = (unsigned)(_r * K + _c) * 2u; }
#define TILE_RC(Lx, BR, BC) do { int wgid = (Lx); \
    { int q = nwg / NXCD, r = nwg % NXCD, xcd = wgid % NXCD, off = wgid / NXCD; wgid = (xcd < r ? xcd * (q + 1) : r * (q + 1) + (xcd - r) * q) + off; } \
    int nig = WGM * nN, gid = wgid / nig, fm = gid * WGM, gsz = min(nM - fm, WGM); \
    BR = (fm + ((wgid % nig) % gsz)) * BM; BC = ((wgid % nig) / gsz) * BM; } while (0)
  int L = blockIdx.x, brow = 0, bcol = 0;
  if (L < nwg) { TILE_RC(L, brow, bcol);
    STAGE(SB(0, 0), Bt, bcol, 0); STAGE(SA(0, 0), A, brow, 0); STAGE(SB(0, 1), Bt, bcol + HALF, 0); STAGE(SA(0, 1), A, brow + HALF, 0);
    STAGE(SB(1, 0), Bt, bcol, 1); STAGE(SA(1, 0), A, brow, 1); STAGE(SB(1, 1), Bt, bcol + HALF, 1); }
  while (L < nwg) {
    f32x4 acc[2][2][4][2];
    for (int a = 0; a < 2; ++a) for (int b = 0; b < 2; ++b) for (int m = 0; m < 4; ++m) for (int n = 0; n < 2; ++n) acc[a][b][m][n] = (f32x4){0.f, 0.f, 0.f, 0.f};
    bf16x8 At[4][2], B0[2][2], B1[2][2];
    if (wr == 1) BAR;
    WAIT_V(0); BAR;
    BAR;
    for (int t = 0; t < nt - 2; t += 2) {
      LDB(B0, 0, 0); SCHED; LDA(At, 0, 0); STAGE(SA(1, 1), A, brow + HALF, t + 1);
      WAIT_L(8); BAR; WAIT_L(0); MMA(0, 0, At, B0); BAR; SCHED;
      LDB(B1, 0, 1); STAGE(SB(0, 0), Bt, bcol, t + 2);
      BAR; WAIT_L(0); MMA(0, 1, At, B1); BAR;
      LDA(At, 0, 1); STAGE(SA(0, 0), A, brow, t + 2);
      BAR; WAIT_L(0); MMA(1, 0, At, B0); BAR; SCHED;
      STAGE(SB(0, 1), Bt, bcol + HALF, t + 2);
      WAIT_V(6); BAR; MMA(1, 1, At, B1); BAR;
      LDB(B0, 1, 0); SCHED; LDA(At, 1, 0); STAGE(SA(0, 1), A, brow + HALF, t + 2);
      WAIT_L(8); BAR; WAIT_L(0); MMA(0, 0, At, B0); BAR; SCHED;
      LDB(B1, 1, 1); STAGE(SB(1, 0), Bt, bcol, t + 3);
      BAR; WAIT_L(0); MMA(0, 1, At, B1); BAR;
      LDA(At, 1, 1); STAGE(SA(1, 0), A, brow, t + 3);
      BAR; WAIT_L(0); MMA(1, 0, At, B0); BAR; SCHED;
      STAGE(SB(1, 1), Bt, bcol + HALF, t + 3);
      WAIT_V(6); BAR; MMA(1, 1, At, B1); BAR;
    }
    { LDB(B0, 0, 0); LDA(At, 0, 0); STAGE(SA(1, 1), A, brow + HALF, nt - 1);
      BAR; WAIT_L(0); MMA(0, 0, At, B0); BAR;
      LDB(B1, 0, 1); BAR; WAIT_L(0); MMA(0, 1, At, B1); BAR;
      LDA(At, 0, 1); WAIT_V(4); BAR; WAIT_L(0); MMA(1, 0, At, B0); MMA(1, 1, At, B1); BAR; }
    { LDB(B0, 1, 0); LDA(At, 1, 0); WAIT_V(2); BAR; WAIT_L(0); MMA(0, 0, At, B0); BAR;
      LDB(B1, 1, 1); WAIT_V(0); BAR; WAIT_L(0); MMA(0, 1, At, B1); BAR;
      LDA(At, 1, 1); BAR; WAIT_L(0); MMA(1, 0, At, B0); MMA(1, 1, At, B1); BAR; }
    if (wr == 0) BAR;
    const int Ln = L + gridDim.x; int nbrow = 0, nbcol = 0;
    if (Ln < nwg) { TILE_RC(Ln, nbrow, nbcol);
      STAGE(SB(0, 0), Bt, nbcol, 0); STAGE(SA(0, 0), A, nbrow, 0); STAGE(SB(0, 1), Bt, nbcol + HALF, 0); STAGE(SA(0, 1), A, nbrow + HALF, 0);
      STAGE(SB(1, 0), Bt, nbcol, 1); STAGE(SA(1, 0), A, nbrow, 1); STAGE(SB(1, 1), Bt, nbcol + HALF, 1); }
    { const int t2 = opaque_tid(wv); const int wid2 = t2 >> 6, lane2 = t2 & 63; epi(acc, brow, bcol, wid2 >> 2, wid2 & 3, lane2 & 15, lane2 >> 4); }
    L = Ln; brow = nbrow; bcol = nbcol;
  }
#undef TILE_RC
#undef SA
#undef SB
#undef STAGE
#undef LDA
#undef LDB
#undef MMA
}

DI float rstd_of(const float* rs, int row) { const f32x4 q = *(const f32x4*)(rs + (size_t)row * 4); return rsqrtf((q[0] + q[1] + q[2] + q[3]) * (1.f / 1024.f) + EPS); }
struct EpiSwiGLU {
  bf16_t* act; const float* rs; const float* sw;
  DI void operator()(const f32x4 (&acc)[2][2][4][2], int brow, int bcol, int wr, int wc, int fr, int fq) const {
    const float* swp = sw + (size_t)cond_of_row(brow) * NCONS + bcol + 64 * wc + 4 * fq;
    f32x4 sv[2][2];
    _Pragma("unroll") for (int bj = 0; bj < 2; ++bj) _Pragma("unroll") for (int n = 0; n < 2; ++n) sv[bj][n] = *(const f32x4*)(swp + 32 * bj + 16 * n);
    _Pragma("unroll") for (int ai = 0; ai < 2; ++ai) _Pragma("unroll") for (int m = 0; m < 4; ++m) {
      const int row = brow + ai * 128 + wr * 64 + m * 16 + fr;
      const float rstd = rstd_of(rs, row);
      u32x4 w4;
      { f32x4 g = acc[ai][0][m][0] * rstd + sv[0][0], u = acc[ai][0][m][1] * rstd + sv[0][1];
        w4.x = pk2(silu_f(g[0]) * u[0], silu_f(g[1]) * u[1]); w4.y = pk2(silu_f(g[2]) * u[2], silu_f(g[3]) * u[3]); }
      { f32x4 g = acc[ai][1][m][0] * rstd + sv[1][0], u = acc[ai][1][m][1] * rstd + sv[1][1];
        w4.z = pk2(silu_f(g[0]) * u[0], silu_f(g[1]) * u[1]); w4.w = pk2(silu_f(g[2]) * u[2], silu_f(g[3]) * u[3]); }
      *(u32x4*)(act + (size_t)row * DFF + ((bcol >> 6) + wc) * 32 + 8 * fq) = w4;
    }
  }
};
struct EpiResid {
  char* ws; const float* gate  ; const float* gnorm; int nid;
  DI void operator()(const f32x4 (&acc)[2][2][4][2], int brow, int bcol, int wr, int wc, int fr, int fq) const {
    __shared__ float s_part[4][256];
    float* X = (float*)(ws + WS_X); bf16_t* XG = (bf16_t*)(ws + WS_H);
    const bool hn = nid < 12; const int nn = hn ? nid : 0;
    float* rs = (float*)(ws + WS_RS) + (size_t)nn * (NTOK * 4);
    const float* ng = gnorm + nn * D;
    const int cond = cond_of_row(brow);
    const float* nsc = (const float*)(ws + WS_MOD) + (size_t)(nn / 3) * 9 * (NMOD * D) + ((nn % 3) * 3 + 1) * D + (size_t)cond * (NMOD * D);
    const int c0 = bcol + 64 * wc + 4 * fq;
    const float* gp = gate + (size_t)cond * (NMOD * D) + c0;
    float* xb = X + (size_t)(brow + wr * 64 + fr) * D + c0;
    float ss[2][4];
    _Pragma("unroll") for (int ai = 0; ai < 2; ++ai) _Pragma("unroll") for (int m = 0; m < 4; ++m) ss[ai][m] = 0.f;
    _Pragma("unroll") for (int bj = 0; bj < 2; ++bj) _Pragma("unroll") for (int n = 0; n < 2; ++n) {
      const int co = 32 * bj + 16 * n;
      const f32x4 gv = *(const f32x4*)(gp + co);
      f32x4 gm = {0.f, 0.f, 0.f, 0.f};
      if (hn) gm = *(const f32x4*)(ng + c0 + co) * (*(const f32x4*)(nsc + c0 + co) + 1.f);
      _Pragma("unroll") for (int ai = 0; ai < 2; ++ai) _Pragma("unroll") for (int m = 0; m < 4; ++m) {
        f32x4* xp = (f32x4*)(xb + (size_t)(ai * 128 + m * 16) * D + co);
        const f32x4 xn = *xp + gv * acc[ai][bj][m][n];
        *xp = xn;
        if (hn) { ss[ai][m] += xn[0] * xn[0] + xn[1] * xn[1] + xn[2] * xn[2] + xn[3] * xn[3];
          const f32x4 h = xn * gm; u32x2 w; w.x = pk2(h[0], h[1]); w.y = pk2(h[2], h[3]);
          *(u32x2*)(XG + (size_t)(brow + ai * 128 + wr * 64 + m * 16 + fr) * D + c0 + co) = w; }
      }
    }
    if (hn) {
      const int lane = fr + 16 * fq;
      _Pragma("unroll") for (int ai = 0; ai < 2; ++ai) _Pragma("unroll") for (int m = 0; m < 4; ++m) {
        float v = ss[ai][m]; v += shx(v, 16, lane); v += shx(v, 32, lane);
        if (fq == 0) s_part[wc][ai * 128 + wr * 64 + m * 16 + fr] = v; }
      __syncthreads();
      const int t = wr * 256 + wc * 64 + lane;
      if (t < 256) rs[(size_t)(brow + t) * 4 + (bcol >> 8)] = s_part[0][t] + s_part[1][t] + s_part[2][t] + s_part[3][t];
    }
  }
};
struct EpiGlaIn {
  bf16_t* buf; float* dg; const float* rs; const float* sw;
  DI void operator()(const f32x4 (&acc)[2][2][4][2], int brow, int bcol, int wr, int wc, int fr, int fq) const {
    const float* swp = sw + (size_t)cond_of_row(brow) * NCONS + bcol + 64 * wc + 4 * fq;
    f32x4 sv[2][2];
    _Pragma("unroll") for (int bj = 0; bj < 2; ++bj) _Pragma("unroll") for (int n = 0; n < 2; ++n) sv[bj][n] = *(const f32x4*)(swp + 32 * bj + 16 * n);
    _Pragma("unroll") for (int ai = 0; ai < 2; ++ai) _Pragma("unroll") for (int m = 0; m < 4; ++m) {
      const int row = brow + ai * 128 + wr * 64 + m * 16 + fr;
      const float rstd = rstd_of(rs, row);
      if (bcol < 3072) {
        _Pragma("unroll") for (int bj = 0; bj < 2; ++bj) {
          const f32x4 v0 = acc[ai][bj][m][0] * rstd + sv[bj][0], v1 = acc[ai][bj][m][1] * rstd + sv[bj][1];
          u32x4 w; w.x = pk2(v0[0], v0[1]); w.y = pk2(v0[2], v0[3]); w.z = pk2(v1[0], v1[1]); w.w = pk2(v1[2], v1[3]);
          *(u32x4*)(buf + (size_t)row * 3072 + bcol + 64 * wc + 32 * bj + 8 * fq) = w;
        }
      } else if (wc == 0) {
        for (int n = 0; n < 2; ++n) *(f32x4*)(dg + (size_t)row * 32 + 8 * fq + 4 * n) = acc[ai][0][m][n] * rstd + sv[0][n];
      }
    }
  }
};
struct EpiPlain {
  bf16_t* buf; int ldc; const float* rs; const float* sw;
  DI void operator()(const f32x4 (&acc)[2][2][4][2], int brow, int bcol, int wr, int wc, int fr, int fq) const {
    const float* swp = sw + (size_t)cond_of_row(brow) * NCONS + bcol + 64 * wc + 4 * fq;
    f32x4 sv[2][2];
    _Pragma("unroll") for (int bj = 0; bj < 2; ++bj) _Pragma("unroll") for (int n = 0; n < 2; ++n) sv[bj][n] = *(const f32x4*)(swp + 32 * bj + 16 * n);
    _Pragma("unroll") for (int ai = 0; ai < 2; ++ai) _Pragma("unroll") for (int m = 0; m < 4; ++m) {
      const int row = brow + ai * 128 + wr * 64 + m * 16 + fr;
      const float rstd = rstd_of(rs, row);
      _Pragma("unroll") for (int bj = 0; bj < 2; ++bj) {
        const f32x4 v0 = acc[ai][bj][m][0] * rstd + sv[bj][0], v1 = acc[ai][bj][m][1] * rstd + sv[bj][1];
        u32x4 w; w.x = pk2(v0[0], v0[1]); w.y = pk2(v0[2], v0[3]); w.z = pk2(v1[0], v1[1]); w.w = pk2(v1[2], v1[3]);
        *(u32x4*)(buf + (size_t)row * ldc + bcol + 64 * wc + 32 * bj + 8 * fq) = w;
      }
    }
  }
};
struct EpiSW {
  float* sw;
  DI void operator()(const f32x4 (&acc)[2][2][4][2], int brow, int bcol, int wr, int wc, int fr, int fq) const {
    const int inst = bcol < 45056 ? bcol / 5632 : (bcol < 50176 ? 8 + (bcol - 45056) / 2560 : 10 + (bcol - 50176) / 3328);
    _Pragma("unroll") for (int m = 0; m < 4; ++m) {
      const int row = wr * 64 + m * 16 + fr;
      const int c = row - inst * 9;
      if (c >= 0 && c < 9) {
        _Pragma("unroll") for (int bj = 0; bj < 2; ++bj) _Pragma("unroll") for (int n = 0; n < 2; ++n)
          *(f32x4*)(sw + (size_t)c * NCONS + bcol + 64 * wc + 32 * bj + 16 * n + 4 * fq) = acc[0][bj][m][n];
      }
    }
  }
};

DI void qkv_post_phase(const Params& p, int i, int wv) {
  extern __shared__ __attribute__((aligned(16))) char smem[];
  const bf16_t* RAW = (const bf16_t*)(p.ws + WS_BIG);
  bf16_t* Q = (bf16_t*)(p.ws + WS_Q); bf16_t* KA = (bf16_t*)(p.ws + WS_KA); bf16_t* VTA = (bf16_t*)(p.ws + WS_VTA); bf16_t* KB = (bf16_t*)(p.ws + WS_KB); bf16_t* VTB = (bf16_t*)(p.ws + WS_VTB);
  float* oak = p.out + OFF_AK + (size_t)i * 256 * 256; float* oav = p.out + OFF_AV + (size_t)i * 256 * 256; float* obk = p.out + OFF_BK + (size_t)i * 256 * 512; float* obv = p.out + OFF_BV + (size_t)i * 256 * 512;
  const int tid = opaque_tid(wv); const int w = tid >> 6, d = tid & 63;
  const float gqd = p.g_qnorm[i * 64 + d], gkd = p.g_knorm[i * 64 + d];
  const float frq = __expf(-(float)(d & 15) * (9.210340371976184f / 16.f));
  for (int grp = blockIdx.x; grp < NTOK / 64; grp += gridDim.x) {
    const int g0 = grp * 64, row0 = g0 + w * 8;
    const bool lat = g0 >= NP;
    int b, tg0, kbase, Tk;
    if (lat) { b = (g0 - NP) >> 10; tg0 = (g0 - NP) & 1023; kbase = NP + b * 1536; Tk = 1536; } else { b = g0 >> 8; tg0 = g0 & 255; kbase = b * 256; Tk = 256; }
    const int t0 = tg0 + w * 8;
    float cs[8], sn[8];
    _Pragma("unroll") for (int rr = 0; rr < 8; ++rr) { const int t = t0 + rr; const float pos = (float)((d < 32) ? (t >> 6) : (t & 63)); const float ang = pos * frq; cs[rr] = __cosf(ang); sn[rr] = __sinf(ang); }
    const bf16_t* rp = RAW + (size_t)row0 * 2560 + d;
    for (int h = 0; h < 40; ++h) {
      float v[8];
      _Pragma("unroll") for (int rr = 0; rr < 8; ++rr) v[rr] = bf2f(rp[(size_t)rr * 2560 + h * 64]);
      int type, head;
      if (h < 8) { type = 0; head = h; } else if (h < 12) { type = 1; head = h - 8; } else if (h < 16) { type = 2; head = h - 12; }
      else if (h < 24) { type = 3; head = h - 16; } else if (h < 32) { type = 4; head = h - 24; } else { type = 5; head = h - 32; }
      const bool isA = type < 3;
      if (type <= 1) {
        float ss[8];
        _Pragma("unroll") for (int rr = 0; rr < 8; ++rr) ss[rr] = v[rr] * v[rr];
        _Pragma("unroll") for (int o = 32; o >= 1; o >>= 1) { _Pragma("unroll") for (int rr = 0; rr < 8; ++rr) ss[rr] += shx(ss[rr], o, d); }
        const float gg = type == 0 ? gqd : gkd;
        _Pragma("unroll") for (int rr = 0; rr < 8; ++rr) v[rr] = v[rr] * rsqrtf(ss[rr] * (1.f / 64.f) + EPS) * gg;
        if (lat) { _Pragma("unroll") for (int rr = 0; rr < 8; ++rr) { const float other = shx(v[rr], 16, d); v[rr] = ((d & 16) == 0) ? (v[rr] * cs[rr] - other * sn[rr]) : (v[rr] * cs[rr] + other * sn[rr]); } }
      }
      if (type == 0 || type == 3) { bf16_t* qp = Q + (size_t)row0 * D + (type == 0 ? 0 : 512) + head * 64 + d;
        _Pragma("unroll") for (int rr = 0; rr < 8; ++rr) qp[(size_t)rr * D] = f2bf(v[rr]); }
      else if (type == 1 || type == 4) {
        bf16_t* kp = (isA ? KA : KB) + ((size_t)head * KSLOTS + kbase + t0) * 64 + d;
        _Pragma("unroll") for (int rr = 0; rr < 8; ++rr) kp[rr * 64] = f2bf(v[rr]);
        if (!lat) { float* op = isA ? (oak + (size_t)b * (2 * 256 * 256) + (size_t)t0 * 256 + head * 64 + d) : (obk + (size_t)b * (2 * 256 * 512) + (size_t)t0 * 512 + head * 64 + d);
          const int st = isA ? 256 : 512; _Pragma("unroll") for (int rr = 0; rr < 8; ++rr) op[rr * st] = v[rr]; }
      } else {
        const int vh = isA ? head : 4 + head;
        u32x4 pk; pk.x = pk2(v[0], v[1]); pk.y = pk2(v[2], v[3]); pk.z = pk2(v[4], v[5]); pk.w = pk2(v[6], v[7]);
        *(u32x4*)(smem + ((vh * 64 + d) * 72 + w * 8) * 2) = pk;
        if (!lat) { float* op = isA ? (oav + (size_t)b * (2 * 256 * 256) + (size_t)t0 * 256 + head * 64 + d) : (obv + (size_t)b * (2 * 256 * 512) + (size_t)t0 * 512 + head * 64 + d);
          const int st = isA ? 256 : 512; _Pragma("unroll") for (int rr = 0; rr < 8; ++rr) op[rr * st] = v[rr]; }
      }
    }
    __syncthreads();
    for (int vh = 0; vh < 12; ++vh) { const int dd = w * 8 + (d >> 3), seg = d & 7;
      const u32x4 val = *(const u32x4*)(smem + ((vh * 64 + dd) * 72 + seg * 8) * 2);
      bf16_t* vt = (vh < 4 ? VTA + ((size_t)vh * KSLOTS + kbase) * 64 : VTB + ((size_t)(vh - 4) * KSLOTS + kbase) * 64);
      *(u32x4*)(vt + (size_t)dd * Tk + tg0 + seg * 8) = val; }
    __syncthreads();
  }
}

struct ConvItem { f32x4 a[4], b[4]; bf16_t* dst; int K, n0, k0; };
DI void conv_load(const Params& p, int item, ConvItem& ci, int wv) {
  const float* src; int ld, nsrc, K, mode = 1, mi0 = 0; bf16_t* dst; int it;
  char* W = p.ws + WS_W;
  if (item < 2816) { int mi = item / 352; it = item % 352; mode = 0; src = nullptr; ld = DFF; nsrc = 5632; K = 1024; dst = (bf16_t*)(W + W_UP + mi * W_UP_STRIDE); mi0 = mi; }
  else if (item < 4224) { int q = item - 2816; int mi = q / 176; it = q % 176; src = p.w_ffn_down + (size_t)mi * DFF * D; ld = D; nsrc = D; K = DFF; dst = (bf16_t*)(W + W_DOWN + mi * W_DOWN_STRIDE); }
  else if (item < 4544) { int q = item - 4224; int mi = q / 160; it = q % 160; src = p.w_attn_in + (size_t)mi * D * 2560; ld = 2560; nsrc = 2560; K = D; mode = 2; dst = (bf16_t*)(W + W_AIN + mi * W_AIN_STRIDE); }
  else if (item < 4672) { int q = item - 4544; int mi = q / 64; it = q % 64; src = p.w_attn_out + (size_t)mi * D * D; ld = D; nsrc = D; K = D; dst = (bf16_t*)(W + W_AOUT + mi * W_OUT_STRIDE); }
  else if (item < 5088) { int q = item - 4672; int mi = q / 208; it = q % 208; src = p.w_gla_in + (size_t)mi * D * 3104; ld = 3104; nsrc = 3104; K = D; mode = 2; dst = (bf16_t*)(W + W_GIN + mi * W_GIN_STRIDE); }
  else { int q = item - 5088; int mi = q / 64; it = q % 64; src = p.w_gla_out + (size_t)mi * D * D; ld = D; nsrc = D; K = D; dst = (bf16_t*)(W + W_GOUT + mi * W_OUT_STRIDE); }
  const int nkb = K / 256; const int nb = it / nkb, kb = it % nkb; const int n0 = nb * 64, k0 = kb * 256;
  const int tid = opaque_tid(wv);
  { const int kk = tid >> 3, part = tid & 7; const int np = n0 + part * 8;
    const int within = np & 255; const int L = (np & ~255) + ((within >> 5) & 3) * 64 + (within >> 7) * 32 + (within & 31);
    const float* s0 = nullptr; size_t rstride = 0; int second = 4;
    if (mode == 0) { const int h_ = within >> 7, wc_ = (within >> 5) & 3, isup = (within >> 4) & 1, fq0 = (within & 15) >> 2;
      const int f = (((np & ~255) >> 6) + wc_) * 32 + 8 * fq0 + 4 * h_; second = 8;
      s0 = (isup ? p.w_ffn_up : p.w_ffn_gate) + (size_t)mi0 * D * DFF + (size_t)(k0 + kk) * DFF + f; rstride = (size_t)64 * DFF; }
    else if (mode == 2) { const int h_ = within >> 7, wc_ = (within >> 5) & 3, n_ = (within >> 4) & 1, fq0 = (within & 15) >> 2;
      const int c0 = (((np & ~255) >> 6) + wc_) * 64 + 32 * h_ + 8 * fq0 + 4 * n_; second = 8;
      if (c0 < nsrc) { s0 = src + (size_t)(k0 + kk) * ld + c0; rstride = (size_t)64 * ld; } }
    else if (L < nsrc) { s0 = src + (size_t)(k0 + kk) * ld + L; rstride = (size_t)64 * ld; }
    _Pragma("unroll") for (int q = 0; q < 4; ++q) { if (s0) { ci.a[q] = *(const f32x4*)(s0 + q * rstride); ci.b[q] = *(const f32x4*)(s0 + q * rstride + second); } else { ci.a[q] = (f32x4){0.f, 0.f, 0.f, 0.f}; ci.b[q] = ci.a[q]; } }
    ci.dst = dst; ci.K = K; ci.n0 = n0; ci.k0 = k0; }
}

DI void conv_finish(const ConvItem& ci, char* smem, int wv) {
  bf16_t* tile = (bf16_t*)smem;
  const int tid = opaque_tid(wv);
  { const int kk = tid >> 3, part = tid & 7;
    _Pragma("unroll") for (int q = 0; q < 4; ++q) { bf16_t* tp = tile + q * (64 * 72) + (part * 8) * 72 + kk;
      tp[0] = f2bf(ci.a[q][0]); tp[72] = f2bf(ci.a[q][1]); tp[144] = f2bf(ci.a[q][2]); tp[216] = f2bf(ci.a[q][3]); tp[288] = f2bf(ci.b[q][0]); tp[360] = f2bf(ci.b[q][1]); tp[432] = f2bf(ci.b[q][2]); tp[504] = f2bf(ci.b[q][3]); } }
  __syncthreads();
  { const int rr = tid >> 3, ks = tid & 7;
    _Pragma("unroll") for (int q = 0; q < 4; ++q) { u32x4 v = *(const u32x4*)(tile + q * (64 * 72) + rr * 72 + ks * 8); *(u32x4*)(ci.dst + (size_t)(ci.n0 + rr) * ci.K + ci.k0 + q * 64 + ks * 8) = v; } }
  __syncthreads();
}

DI void prep_phase(const Params& p, int wv) {
  extern __shared__ __attribute__((aligned(16))) char smem[];
  const int tid = opaque_tid(wv), G = gridDim.x;
  { f32x4* X = (f32x4*)(p.ws + WS_X); const f32x4* a = (const f32x4*)p.x_prompt; const f32x4* b = (const f32x4*)p.x_sample; const long half = (long)NP * D / 4;
    for (long i = (long)blockIdx.x * 512 + tid; i < 2 * half; i += (long)G * 512) X[i] = i < half ? a[i] : b[i - half]; }
  { float* sc = (float*)smem;
    float* red = sc + 9 * 1024;
    for (int i = tid; i < 9 * 1024; i += 512) { const int c = i >> 10, k = i & 1023; const float v = c == 0 ? p.c_ctx[k] : p.c[(c - 1) * D + k]; sc[i] = silu_f(v); }
    __syncthreads();
    float* MOD = (float*)(p.ws + WS_MOD);
    const int w = tid >> 6, lane = tid & 63;
    for (int it = blockIdx.x; it < 4 * 144; it += G) {
      const int l = it / 144, cgp = it % 144; const int col = cgp * 64 + lane;
      const float* wp = p.w_mod + ((size_t)l * D + w * 128) * (NMOD * D) + col;
      float a[9]; for (int c = 0; c < 9; ++c) a[c] = 0.f;
      for (int k0 = 0; k0 < 128; k0 += 32) { float wgt[32];
        _Pragma("unroll") for (int k = 0; k < 32; ++k) wgt[k] = wp[(size_t)(k0 + k) * (NMOD * D)];
        _Pragma("unroll") for (int k = 0; k < 32; ++k) { _Pragma("unroll") for (int c = 0; c < 9; ++c) a[c] += sc[c * 1024 + w * 128 + k0 + k] * wgt[k]; } }
      for (int c = 0; c < 9; ++c) red[(w * 9 + c) * 64 + lane] = a[c];
      __syncthreads();
      for (int i = tid; i < 576; i += 512) { const int c = i >> 6, ln = i & 63; float s = 0.f; for (int ww = 0; ww < 8; ++ww) s += red[(ww * 9 + c) * 64 + ln];
        const int slot_ = (cgp * 64 + ln) >> 10;
        const float mv = (s + p.b_mod[(size_t)l * (NMOD * D) + cgp * 64 + ln]) * ((slot_ == 2 || slot_ == 8) ? 0.5f : 1.f);
        MOD[((size_t)l * 9 + c) * (NMOD * D) + cgp * 64 + ln] = mv;
        const int jj = cgp * 64 + ln, slot = jj >> 10, kk2 = jj & 1023;
        if (slot == 0 || slot == 3 || slot == 6) { const int inst = slot == 0 ? l * 2 : (slot == 6 ? l * 2 + 1 : ((l & 1) ? 10 + (l >> 1) : 8 + (l >> 1)));
          ((bf16_t*)(p.ws + WS_SH))[(size_t)(inst * 9 + c) * 1024 + kk2] = f2bf(mv); } }
      __syncthreads();
    }
  }
  { u32x4* z = (u32x4*)(p.ws + WS_SH + 108 * 2048); const u32x4 zz = {0u, 0u, 0u, 0u}; for (int i = blockIdx.x * 512 + tid; i < 148 * 128; i += G * 512) z[i] = zz; }
  { ConvItem c0, c1; int item = blockIdx.x;
    if (item < 5216) conv_load(p, item, c0, wv);
    while (item < 5216) {
      if (item + G < 5216) conv_load(p, item + G, c1, wv);
      conv_finish(c0, smem, wv);
      item += G; if (item >= 5216) break;
      if (item + G < 5216) conv_load(p, item + G, c0, wv);
      conv_finish(c1, smem, wv);
      item += G;
    } }
}

DI void norm_phase(const Params& p, const float* g, const float* modp, bool final_, int wv) {
  const float* X = (const float*)(p.ws + WS_X); bf16_t* H = (bf16_t*)(p.ws + WS_H);
  const int tidn = opaque_tid(wv); const int w = tidn >> 6, lane = tidn & 63;
  for (int row = blockIdx.x * 8 + w; row < NTOK; row += gridDim.x * 8) {
    const float* xp = X + (size_t)row * D;
    f32x4 v[4]; float ss = 0.f;
    for (int i = 0; i < 4; ++i) { v[i] = *(const f32x4*)(xp + 4 * (lane + 64 * i)); ss += v[i][0] * v[i][0] + v[i][1] * v[i][1] + v[i][2] * v[i][2] + v[i][3] * v[i][3]; }
    for (int o = 32; o >= 1; o >>= 1) ss += shx(ss, o, lane);
    const float rstd = rsqrtf(ss * (1.f / 1024.f) + EPS);
    if (final_) {
      for (int i = 0; i < 4; ++i) { const int col = 4 * (lane + 64 * i); f32x4 gg = *(const f32x4*)(g + col); *(f32x4*)(p.out + (size_t)row * D + col) = v[i] * rstd * gg; }
    } else {
      const float* mp = modp + (size_t)cond_of_row(row) * (NMOD * D);
      for (int i = 0; i < 4; ++i) { const int col = 4 * (lane + 64 * i); f32x4 gg = *(const f32x4*)(g + col), sh = *(const f32x4*)(mp + col), scl = *(const f32x4*)(mp + D + col);
        f32x4 h = v[i] * rstd * gg * (scl + 1.f) + sh; u32x2 o; o.x = pk2(h[0], h[1]); o.y = pk2(h[2], h[3]); *(u32x2*)(H + (size_t)row * D + col) = o; }
    }
  }
}

DI void cache_phase(const Params& p, int i, int wv) {
  bf16_t* KA = (bf16_t*)(p.ws + WS_KA); bf16_t* VTA = (bf16_t*)(p.ws + WS_VTA); bf16_t* KB = (bf16_t*)(p.ws + WS_KB); bf16_t* VTB = (bf16_t*)(p.ws + WS_VTB);
  const long nA = 8L * 512 * 256, nB = 8L * 512 * 512;
  const int tidc = opaque_tid(wv);
  for (long e = (long)blockIdx.x * 512 + tidc; e < nA + nB; e += (long)gridDim.x * 512) {
    if (e < nA) { const int d = e & 63, hd = (e >> 6) & 3, t = (e >> 8) & 511, b = (int)(e >> 17);
      const size_t si = ((((size_t)b * 2 + i) * 512 + t) * 4 + hd) * 64 + d; const size_t kb = (size_t)hd * KSLOTS + NP + b * 1536;
      KA[(kb + 1024 + t) * 64 + d] = f2bf(p.cache_a_k[si]); }
    else { const long q = e - nA; const int d = q & 63, hd = (q >> 6) & 7, t = (q >> 9) & 511, b = (int)(q >> 18);
      const size_t si = ((((size_t)b * 2 + i) * 512 + t) * 8 + hd) * 64 + d; const size_t kb = (size_t)hd * KSLOTS + NP + b * 1536;
      KB[(kb + 1024 + t) * 64 + d] = f2bf(p.cache_b_k[si]); }
  }
  const long uA = 8L * 4 * 64 * 64, uB = 8L * 8 * 64 * 64;
  for (long u = (long)blockIdx.x * 512 + tidc; u < uA + uB; u += (long)gridDim.x * 512) {
    const bool isA = u < uA; const long q = isA ? u : u - uA; const int nh = isA ? 4 : 8;
    const int d = q & 63; const int t8 = (q >> 6) & 63; const int hd = (int)((q >> 12) % nh); const int b = (int)((q >> 12) / nh);
    const float* src = (isA ? p.cache_a_v : p.cache_b_v) + ((((size_t)b * 2 + i) * 512 + t8 * 8) * nh + hd) * 64 + d;
    float v[8];
    _Pragma("unroll") for (int k = 0; k < 8; ++k) v[k] = src[(size_t)k * nh * 64];
    u32x4 pk; pk.x = pk2(v[0], v[1]); pk.y = pk2(v[2], v[3]); pk.z = pk2(v[4], v[5]); pk.w = pk2(v[6], v[7]);
    bf16_t* vt = (isA ? VTA : VTB) + ((size_t)hd * KSLOTS + NP + b * 1536) * 64 + (size_t)d * 1536 + 1024 + t8 * 8;
    *(u32x4*)vt = pk;
  }
}

struct AttnState { f32x16 O0, O1; float m, l; };
struct KVFrag { bf16x8 k[4]; s16x4 v[8]; };
DI void attn_compute(AttnState& st, const bf16x8 (&Qf)[4], const KVFrag& f, int r, int hh, bool na, int kc0, int qc, const float* brow_) {
  f32x16 S = zero16();
  _Pragma("unroll") for (int s = 0; s < 4; ++s) S = MFMA32(f.k[s], Qf[s], S);
  const float sc = 0.125f * 1.4426950408889634f;
  if (na) {
    const int ws = min(max(qc - 8, 0), 48);
    _Pragma("unroll") for (int i = 0; i < 16; ++i) { const int kc = kc0 + crow(i, hh); const bool ok = (kc >= ws) && (kc < ws + 16);
      const float bias = brow_[ok ? (kc - qc + 15) : 15];
      S[i] = ok ? (S[i] * sc + bias * 1.4426950408889634f) : -INFINITY; }
  } else { _Pragma("unroll") for (int i = 0; i < 16; ++i) S[i] *= sc; }
  float mx = S[0]; _Pragma("unroll") for (int i = 1; i < 16; ++i) mx = fmaxf(mx, S[i]);
  mx = fmaxf(mx, shx(mx, 32, r + 32 * hh));
  const float mn = fmaxf(st.m, mx);
  const float alpha = __builtin_amdgcn_exp2f(st.m - mn);
  float rs = 0.f;
  _Pragma("unroll") for (int i = 0; i < 16; ++i) { S[i] = __builtin_amdgcn_exp2f(S[i] - mn); rs += S[i]; }
  rs += shx(rs, 32, r + 32 * hh);
  st.l = st.l * alpha + rs; st.m = mn;
  _Pragma("unroll") for (int i = 0; i < 16; ++i) { st.O0[i] *= alpha; st.O1[i] *= alpha; }
  const bf16x8 P0 = pack_lo(S), P1 = pack_hi(S);
  st.O0 = MFMA32(join4(f.v[0], f.v[1]), P0, st.O0); st.O0 = MFMA32(join4(f.v[2], f.v[3]), P1, st.O0);
  st.O1 = MFMA32(join4(f.v[4], f.v[5]), P0, st.O1); st.O1 = MFMA32(join4(f.v[6], f.v[7]), P1, st.O1);
}

constexpr int AT_K = 0, AT_V = 9216, AT_BUF = 18432;
DI void lds_kv(KVFrag& f, const char* buf, int sb, int r, int hh) {
  const char* kp = buf + AT_K + (32 * sb + r) * 144 + 16 * hh;
  _Pragma("unroll") for (int s = 0; s < 4; ++s) f.k[s] = *(const bf16x8*)(kp + 32 * s);
  const char* v0 = buf + AT_V + r * 144 + 64 * sb + 8 * hh; const char* v1 = v0 + 32 * 144;
  _Pragma("unroll") for (int q = 0; q < 4; ++q) { f.v[q] = *(const s16x4*)(v0 + 16 * q); f.v[4 + q] = *(const s16x4*)(v1 + 16 * q); }
}
DI void attn_phase(const Params& p, int ia, int wv) {
  extern __shared__ __attribute__((aligned(16))) char smem[];
  const bf16_t* Q = (const bf16_t*)(p.ws + WS_Q); const bf16_t* KA = (const bf16_t*)(p.ws + WS_KA); const bf16_t* VTA = (const bf16_t*)(p.ws + WS_VTA);
  const bf16_t* KB = (const bf16_t*)(p.ws + WS_KB); const bf16_t* VTB = (const bf16_t*)(p.ws + WS_VTB); bf16_t* O = (bf16_t*)(p.ws + WS_O);
  const int tida = opaque_tid(wv); const int w = tida >> 6, lane = tida & 63, r = lane & 31, hh = lane >> 5;
  const int l_row = tida >> 3, l_pc = tida & 7; const int l_dst = l_row * 144 + l_pc * 16;
  for (int item0 = blockIdx.x; item0 < 1024; item0 += gridDim.x) {
    const int item = (item0 & ~255) | ((item0 & 7) << 5) | ((item0 & 255) >> 3);
    int qrow0, qcol, Tk, nstep_plain, plain0, mode; const bf16_t *Kb, *Vb; int b = 0, head = 0, qr = 0, c0 = 0, R0 = 0, nrows = 0;
    if (item < 256) { b = item >> 5; head = (item >> 2) & 7; const int qb = item & 3; mode = 0;
      qrow0 = NP + b * 1024 + qb * 256 + w * 32; qcol = head * 64; Tk = 1536; const size_t kb = (size_t)(head >> 1) * KSLOTS + NP + b * 1536;
      Kb = KA + kb * 64; Vb = VTA + kb * 64; nstep_plain = 24; plain0 = 0; }
    else if (item < 512) { const int q = item - 256; b = q >> 5; head = (q >> 2) & 7; const int rg = q & 3; mode = 1;
      qr = rg * 4 + (w >> 1); c0 = (w & 1) * 32; qrow0 = NP + b * 1024 + qr * 64 + c0; qcol = 512 + head * 64; Tk = 1536; const size_t kb = (size_t)head * KSLOTS + NP + b * 1536;
      Kb = KB + kb * 64; Vb = VTB + kb * 64; nstep_plain = 8; plain0 = 1024;
      R0 = min(max(rg * 4 - 4, 0), 8); nrows = min(max(rg * 4 + 3 - 4, 0), 8) + 8 - R0; }
    else { const int q = item - 512; b = q >> 4; const int mixer = (q >> 3) & 1; head = q & 7; mode = 2;
      qrow0 = b * 256 + w * 32; qcol = mixer * 512 + head * 64; Tk = 256; const size_t kb = (size_t)(mixer ? head : (head >> 1)) * KSLOTS + b * 256;
      Kb = (mixer ? KB : KA) + kb * 64; Vb = (mixer ? VTB : VTA) + kb * 64; nstep_plain = 4; plain0 = 0; }
    bf16x8 Qf[4];
    for (int s = 0; s < 4; ++s) Qf[s] = *(const bf16x8*)(Q + (size_t)(qrow0 + r) * D + qcol + 16 * s + 8 * hh);
    AttnState st; st.O0 = zero16(); st.O1 = zero16(); st.m = -1e30f; st.l = 0.f;
    const int rs0 = min(max(qr - 4, 0), 8); const float* rb = p.na_rel_bias + ((size_t)ia * 8 + head) * 15 * 31;
    const int ntot = nstep_plain + (mode == 1 ? nrows : 0);
#define SK0(idx) ((idx) < nstep_plain ? plain0 + 64 * (idx) : (R0 + (idx) - nstep_plain) * 64)
#define GK(k0_) (*(const u32x4*)(Kb + (size_t)((k0_) + l_row) * 64 + l_pc * 8))
#define GV(k0_) (*(const u32x4*)(Vb + (size_t)l_row * Tk + (k0_) + l_pc * 8))
    u32x4 sk0 = GK(SK0(0)), sv0 = GV(SK0(0)), sk1 = GK(SK0(1)), sv1 = GV(SK0(1));
    for (int idx = 0; idx < ntot; idx += 2) {
      _Pragma("unroll") for (int par = 0; par < 2; ++par) {
        const int ii = idx + par;
        if (ii < ntot) {
          char* buf = smem + par * AT_BUF;
          *(u32x4*)(buf + AT_K + l_dst) = par ? sk1 : sk0; *(u32x4*)(buf + AT_V + l_dst) = par ? sv1 : sv0;
          __syncthreads();
          if (ii + 2 < ntot) { const int kn = SK0(ii + 2); if (par) { sk1 = GK(kn); sv1 = GV(kn); } else { sk0 = GK(kn); sv0 = GV(kn); } }
          const bool na_ = ii >= nstep_plain; const int kr = R0 + ii - nstep_plain;
          if (!na_ || (kr >= rs0 && kr < rs0 + 8)) {
            _Pragma("unroll") for (int sb = 0; sb < 2; ++sb) { KVFrag f; lds_kv(f, buf, sb, r, hh);
              attn_compute(st, Qf, f, r, hh, na_, 32 * sb, c0 + r, rb + (kr - qr + 7) * 31); }
          }
        }
      }
    }
    __syncthreads();
#undef SK0
#undef GK
#undef GV
    const float inv = 1.f / st.l;
    bf16_t* op = O + (size_t)(qrow0 + r) * D + qcol;
    for (int g4 = 0; g4 < 4; ++g4) { const int d0 = 8 * g4 + 4 * hh;
      u32x2 a; a.x = pk2(st.O0[4 * g4] * inv, st.O0[4 * g4 + 1] * inv); a.y = pk2(st.O0[4 * g4 + 2] * inv, st.O0[4 * g4 + 3] * inv); *(u32x2*)(op + d0) = a;
      u32x2 c; c.x = pk2(st.O1[4 * g4] * inv, st.O1[4 * g4 + 1] * inv); c.y = pk2(st.O1[4 * g4 + 2] * inv, st.O1[4 * g4 + 3] * inv); *(u32x2*)(op + 32 + d0) = c; }
  }
}

constexpr int G_QIN = 0, G_KIN = 17408, G_KOT = 34816, G_VT = 53248, G_TOT = 90112, G_DEC = 92160, G_DL = 92672;
DI void gla_item(const Params& p, int j, int rowbase, int T, int bout, int bstate, int hd, int dir, char* smem, int wv) {
  const bf16_t* GB = (const bf16_t*)(p.ws + WS_BIG + BIG_GLABUF); const float* DG = (const float*)(p.ws + WS_BIG + BIG_DG);
  bf16_t* OX = (bf16_t*)(p.ws + WS_BIG + (dir ? BIG_OB : BIG_OF));
  const int tid = opaque_tid(wv), w = tid >> 6, lane = tid & 63, r = lane & 31, hh = lane >> 5;
  const int dk = tid & 127, pg = tid >> 7;
  float* TOT = (float*)(smem + G_TOT); float* DEC = (float*)(smem + G_DEC); float* DL = (float*)(smem + G_DL);
  float wcol[16]; const float* wg = p.w_gla_gup + (((size_t)j * 2 + dir) * 16) * 512 + hd * 128 + dk;
  for (int q = 0; q < 16; ++q) wcol[q] = wg[q * 512];
  const float bcol_ = p.b_gla_gup[((size_t)j * 2 + dir) * 512 + hd * 128 + dk];
  f32x16 S[4];
  if (bstate >= 0) { const float* sp = p.state_gla + ((((size_t)bstate * 2 + j) * 2 + dir) * 4 + hd) * 128 * 256 + 32 * w + r;
    for (int blk = 0; blk < 4; ++blk) for (int i = 0; i < 16; ++i) S[blk][i] = sp[(size_t)(32 * blk + crow(i, hh)) * 256]; }
  else { for (int blk = 0; blk < 4; ++blk) S[blk] = zero16(); }
  const int nchunk = T / 64;
#define ROWOFC(cc, pp) (rowbase + (dir ? (T - 1 - ((cc) * 64 + (pp))) : ((cc) * 64 + (pp))))
  if (tid < 256) { const int pp = tid >> 2, qq = tid & 3; *(f32x4*)(DL + pp * 16 + qq * 4) = *(const f32x4*)(DG + (size_t)ROWOFC(0, pp) * 32 + dir * 16 + qq * 4); }
  __syncthreads();
  for (int ci = 0; ci < nchunk; ++ci) {
#define ROWOF(pp) ROWOFC(ci, pp)
    f32x4 dlnext = {0.f, 0.f, 0.f, 0.f};
    if (tid < 256 && ci + 1 < nchunk) dlnext = *(const f32x4*)(DG + (size_t)ROWOFC(ci + 1, tid >> 2) * 32 + dir * 16 + (tid & 3) * 4);
    float bl[16]; { float run = 0.f;
      _Pragma("unroll") for (int e = 0; e < 16; e += 2) { const float* dl = DL + (pg * 16 + e) * 16; f32x2 z2 = {bcol_, bcol_};
        _Pragma("unroll") for (int q4 = 0; q4 < 4; ++q4) { const f32x4 d0 = *(const f32x4*)(dl + 4 * q4), d1 = *(const f32x4*)(dl + 16 + 4 * q4);
          _Pragma("unroll") for (int q = 0; q < 4; ++q) { const f32x2 dd = {d0[q], d1[q]}; z2 += dd * wcol[4 * q4 + q]; } }
        _Pragma("unroll") for (int u = 0; u < 2; ++u) { const float z = z2[u]; const float ls = fminf(z, 0.f) - __logf(1.f + __expf(-fabsf(z))); run += ls * (1.f / 16.f); bl[e + u] = run; } }
      TOT[pg * 128 + dk] = run; }
    __syncthreads();
    { float off = 0.f, blast = 0.f; for (int g = 0; g < 4; ++g) { const float tv = TOT[g * 128 + dk]; blast += tv; if (g < pg) off += tv; }
      const float eblast = __expf(blast);
      if (pg == 0) DEC[dk] = eblast;
      unsigned ko[8];
      for (int e = 0; e < 16; e += 2) { float kv[2];
        for (int u = 0; u < 2; ++u) { const int pp = pg * 16 + e + u; const size_t rb = (size_t)ROWOF(pp) * 3072 + hd * 128 + dk; const float bb = bl[e + u] + off;
          const float qv = bf2f(GB[rb]) * 0.08838834764831845f, kk = bf2f(GB[rb + 512]);
          const float eb = __expf(bb), kin = kk * __builtin_amdgcn_rcpf(eb);
          *(bf16_t*)(smem + G_QIN + pp * 272 + dk * 2) = f2bf(qv * eb); *(bf16_t*)(smem + G_KIN + pp * 272 + dk * 2) = f2bf(kin); kv[u] = kin * eblast; }
        ko[e >> 1] = pk2(kv[0], kv[1]); }
      u32x4 k0; k0.x = ko[0]; k0.y = ko[1]; k0.z = ko[2]; k0.w = ko[3]; u32x4 k1; k1.x = ko[4]; k1.y = ko[5]; k1.z = ko[6]; k1.w = ko[7];
      *(u32x4*)(smem + G_KOT + dk * 144 + pg * 32) = k0; *(u32x4*)(smem + G_KOT + dk * 144 + pg * 32 + 16) = k1; }
    { const int dv = tid & 255, hf = tid >> 8;
      for (int e8 = 0; e8 < 4; ++e8) { float vv[8];
        for (int u = 0; u < 8; ++u) { const int pp = hf * 32 + e8 * 8 + u; vv[u] = bf2f(GB[(size_t)ROWOF(pp) * 3072 + 1024 + hd * 256 + dv]); }
        u32x4 o; o.x = pk2(vv[0], vv[1]); o.y = pk2(vv[2], vv[3]); o.z = pk2(vv[4], vv[5]); o.w = pk2(vv[6], vv[7]);
        *(u32x4*)(smem + G_VT + dv * 144 + hf * 64 + e8 * 16) = o; } }
    __syncthreads();
    bf16x8 Sp[4][2];
    for (int blk = 0; blk < 4; ++blk) { Sp[blk][0] = pack_lo(S[blk]); Sp[blk][1] = pack_hi(S[blk]); }
    f32x16 aT[3];
    for (int ti = 0; ti < 3; ++ti) { const int kt = ti == 2 ? 1 : 0, qt = ti == 0 ? 0 : 1; f32x16 a = zero16();
      for (int s = 0; s < 8; ++s) { bf16x8 A = *(const bf16x8*)(smem + G_KIN + (32 * kt + r) * 272 + (16 * s + 8 * hh) * 2); bf16x8 B = *(const bf16x8*)(smem + G_QIN + (32 * qt + r) * 272 + (16 * s + 8 * hh) * 2); a = MFMA32(A, B, a); }
      if (kt == qt) for (int i = 0; i < 16; ++i) a[i] = (crow(i, hh) <= r) ? a[i] : 0.f;
      aT[ti] = a; }
    const char* vrow = smem + G_VT + (32 * w + r) * 144;
    for (int qt = 0; qt < 2; ++qt) { f32x16 o = zero16();
      for (int kt = 0; kt <= qt; ++kt) { const f32x16& a = (qt == 0) ? aT[0] : (kt == 0 ? aT[1] : aT[2]);
        bf16x8 A0 = pack_lo(a), A1 = pack_hi(a);
        bf16x8 B0 = join4(*(const s16x4*)(vrow + (32 * kt + 4 * hh) * 2), *(const s16x4*)(vrow + (32 * kt + 8 + 4 * hh) * 2));
        bf16x8 B1 = join4(*(const s16x4*)(vrow + (32 * kt + 16 + 4 * hh) * 2), *(const s16x4*)(vrow + (32 * kt + 24 + 4 * hh) * 2));
        o = MFMA32(A0, B0, o); o = MFMA32(A1, B1, o); }
      const char* qrow_ = smem + G_QIN + (32 * qt + r) * 272;
      for (int blk = 0; blk < 4; ++blk) for (int s = 0; s < 2; ++s) {
        bf16x8 A2 = join4(*(const s16x4*)(qrow_ + (32 * blk + 16 * s + 4 * hh) * 2), *(const s16x4*)(qrow_ + (32 * blk + 16 * s + 8 + 4 * hh) * 2));
        o = MFMA32(A2, Sp[blk][s], o); }
      for (int i = 0; i < 16; ++i) { const int pp = 32 * qt + crow(i, hh); OX[(size_t)ROWOF(pp) * D + hd * 256 + 32 * w + r] = f2bf(o[i]); } }
    for (int blk = 0; blk < 4; ++blk) { f32x16 s_ = S[blk];
      for (int i = 0; i < 16; ++i) s_[i] *= DEC[32 * blk + crow(i, hh)];
      for (int s = 0; s < 4; ++s) { bf16x8 A = *(const bf16x8*)(smem + G_KOT + (32 * blk + r) * 144 + (16 * s + 8 * hh) * 2); bf16x8 B = *(const bf16x8*)(vrow + (16 * s + 8 * hh) * 2); s_ = MFMA32(A, B, s_); }
      S[blk] = s_; }
    if (tid < 256) *(f32x4*)(DL + (tid >> 2) * 16 + (tid & 3) * 4) = dlnext;
    __syncthreads();
#undef ROWOF
  }
  if (bout >= 0) { float* op = p.out + OFF_GLA + ((((size_t)bout * 2 + j) * 2 + dir) * 4 + hd) * 128 * 256 + 32 * w + r;
    for (int blk = 0; blk < 4; ++blk) for (int i = 0; i < 16; ++i) op[(size_t)(32 * blk + crow(i, hh)) * 256] = S[blk][i]; }
}
DI void gla_phase(const Params& p, int j, int wv) {
  extern __shared__ __attribute__((aligned(16))) char smem[];
  const int G = gridDim.x, bid = blockIdx.x;
  if (G > 64) {
    if (bid < 64) { const int b = bid >> 3, hd = (bid >> 1) & 3, dir = bid & 1; gla_item(p, j, NP + b * 1024, 1024, -1, b, hd, dir, smem, wv); }
    else for (int it = bid - 64; it < 256; it += G - 64) { const int b = it >> 3, hd = (it >> 1) & 3, dir = it & 1; gla_item(p, j, b * 256, 256, b, -1, hd, dir, smem, wv); }
  } else {
    for (int it = bid; it < 320; it += G) {
      if (it < 64) { const int b = it >> 3, hd = (it >> 1) & 3, dir = it & 1; gla_item(p, j, NP + b * 1024, 1024, -1, b, hd, dir, smem, wv); }
      else { const int q = it - 64; const int b = q >> 3, hd = (q >> 1) & 3, dir = q & 1; gla_item(p, j, b * 256, 256, b, -1, hd, dir, smem, wv); } }
  }
}
DI void gla_post_phase(const Params& p, int j, int wv) {
  const bf16_t* GB = (const bf16_t*)(p.ws + WS_BIG + BIG_GLABUF); const bf16_t* OF = (const bf16_t*)(p.ws + WS_BIG + BIG_OF); const bf16_t* OB = (const bf16_t*)(p.ws + WS_BIG + BIG_OB);
  bf16_t* O = (bf16_t*)(p.ws + WS_O); const float* gn = p.g_gla_norm + j * 256;
  const int tidp = opaque_tid(wv); const int w = tidp >> 6, lane = tidp & 63;
  for (int row = blockIdx.x * 8 + w; row < NTOK; row += gridDim.x * 8) {
    const int col = 16 * lane; float o[16]; float ss = 0.f;
    for (int e = 0; e < 16; ++e) { o[e] = bf2f(OF[(size_t)row * D + col + e]) + bf2f(OB[(size_t)row * D + col + e]); ss += o[e] * o[e]; }
    for (int x = 8; x >= 1; x >>= 1) ss += shx(ss, x, lane);
    const float rstd = rsqrtf(ss * (1.f / 256.f) + EPS);
    unsigned pk[8];
    for (int e = 0; e < 16; e += 2) { float y[2];
      for (int u = 0; u < 2; ++u) { const float g = bf2f(GB[(size_t)row * 3072 + 2048 + col + e + u]); y[u] = o[e + u] * rstd * gn[(col & 255) + e + u] * silu_f(g); }
      pk[e >> 1] = pk2(y[0], y[1]); }
    u32x4 a; a.x = pk[0]; a.y = pk[1]; a.z = pk[2]; a.w = pk[3]; u32x4 b; b.x = pk[4]; b.y = pk[5]; b.z = pk[6]; b.w = pk[7];
    *(u32x4*)(O + (size_t)row * D + col) = a; *(u32x4*)(O + (size_t)row * D + col + 8) = b;
  }
}

DI void init_xg_phase(const Params& p, int wv) {
  const float* X = (const float*)(p.ws + WS_X); bf16_t* XG = (bf16_t*)(p.ws + WS_H); float* RS = (float*)(p.ws + WS_RS);
  const float* g = p.g_norm; const float* MOD = (const float*)(p.ws + WS_MOD);
  const int tidn = opaque_tid(wv); const int w = tidn >> 6, lane = tidn & 63;
  for (int row = blockIdx.x * 8 + w; row < NTOK; row += gridDim.x * 8) {
    const float* xp = X + (size_t)row * D; const float* mp = MOD + (size_t)cond_of_row(row) * (NMOD * D) + D;
    float ss = 0.f;
    for (int i = 0; i < 4; ++i) { const int col = 4 * (lane + 64 * i); const f32x4 v = *(const f32x4*)(xp + col);
      ss += v[0] * v[0] + v[1] * v[1] + v[2] * v[2] + v[3] * v[3];
      const f32x4 h = v * *(const f32x4*)(g + col) * (*(const f32x4*)(mp + col) + 1.f);
      u32x2 o; o.x = pk2(h[0], h[1]); o.y = pk2(h[2], h[3]); *(u32x2*)(XG + (size_t)row * D + col) = o; }
    for (int o = 32; o >= 1; o >>= 1) ss += shx(ss, o, lane);
    if (lane == 0) { f32x4 q = {ss, 0.f, 0.f, 0.f}; *(f32x4*)(RS + (size_t)row * 4) = q; }
  }
}
#define XB_TMO      128
#define XB_XCNT(j)  (256  + 64 * (j))
#define XB_XSUB(j)  (1280 + 64 * (j))
#define XB_XGEN(j)  (2304 + 64 * (j))
#define XB_TOP      3328
#define XB_TOPGEN   3392
#define XCD_BAR_WORDS 3456
#define XB_SPIN_CAP (1u << 20)
DI unsigned xb_ld(unsigned* p) { return __hip_atomic_load(p, __ATOMIC_RELAXED, __HIP_MEMORY_SCOPE_AGENT); }
DI unsigned xb_add(unsigned* p, unsigned v) { return __hip_atomic_fetch_add(p, v, __ATOMIC_RELAXED, __HIP_MEMORY_SCOPE_AGENT); }
DI unsigned xb_xcc_id() { return (unsigned)__builtin_amdgcn_s_getreg((3 << 11) | 20) & 0xFu; }
#define XB_SPIN(cond, bar) do { unsigned _sp = 0; while (cond) { __builtin_amdgcn_s_sleep(1); \
    if ((++_sp & 255u) == 0u) { if (xb_ld(&(bar)[XB_TMO])) break; if (_sp > XB_SPIN_CAP) { atomicAdd(&(bar)[XB_TMO], 1u); break; } } } } while (0)
DI void xcd_barrier_complete(unsigned* bar, unsigned x, unsigned& nloc, unsigned& nx) {
  const unsigned G = gridDim.x;
  unsigned sum, cnt, mine, sp = 0u;
  for (;;) {
    sum = 0u; cnt = 0u; mine = 0u;
    _Pragma("unroll") for (unsigned j = 0; j < 16; ++j) { const unsigned c = xb_ld(&bar[XB_XCNT(j)]); sum += c; cnt += (c > 0u) ? 1u : 0u; mine = (j == x) ? c : mine; }
    if (sum == G) break;
    __builtin_amdgcn_s_sleep(1);
    if ((++sp & 255u) == 0u) { if (xb_ld(&bar[XB_TMO])) break; if (sp > XB_SPIN_CAP) { atomicAdd(&bar[XB_TMO], 1u); break; } }
  }
  nloc = mine > 0u ? mine : 1u; nx = cnt > 0u ? cnt : 1u;
}
DI void grid_bar(unsigned* bar, volatile unsigned* st  , int wv) {
  asm volatile("s_waitcnt vmcnt(0)" ::: "memory");
  __syncthreads();
  const int tid = opaque_tid(wv);
  if (tid == 0) {
    __builtin_amdgcn_s_waitcnt(0);
    const unsigned x = xb_xcc_id();
    unsigned nloc = st[0], nx = st[1];
    if (nloc == 0u) { xcd_barrier_complete(bar, x, nloc, nx); st[0] = nloc; st[1] = nx; }
    const unsigned old = xb_add(&bar[XB_XSUB(x)], 1u);
    const unsigned gen = old / nloc;
    if (old + 1u == (gen + 1u) * nloc) {
      __builtin_amdgcn_fence(__ATOMIC_RELEASE, "agent");
      asm volatile("s_waitcnt vmcnt(0)" ::: "memory");
      const unsigned og = xb_add(&bar[XB_TOP], 1u);
      const unsigned tg = og / nx;
      if (og + 1u == (tg + 1u) * nx) xb_add(&bar[XB_TOPGEN], 1u);
      else XB_SPIN(xb_ld(&bar[XB_TOPGEN]) == tg, bar);
      __builtin_amdgcn_fence(__ATOMIC_ACQUIRE, "agent");
      xb_add(&bar[XB_XGEN(x)], 1u);
      asm volatile("s_waitcnt vmcnt(0)" ::: "memory");
    } else {
      XB_SPIN(xb_ld(&bar[XB_XGEN(x)]) == gen, bar);
      __builtin_amdgcn_fence(__ATOMIC_ACQUIRE, "agent");
      asm volatile("s_waitcnt vmcnt(0)" ::: "memory");
    }
  }
  __syncthreads();
}
__global__ void __launch_bounds__(512, 2) mega(Params p) {
  cg::grid_group grid = cg::this_grid();
  const int wv = __builtin_amdgcn_readfirstlane(threadIdx.x >> 6);
  unsigned* barctr = (unsigned*)(p.ws + WS_BAR);
  __shared__ unsigned xb_words[4];
  if (threadIdx.x < 4) xb_words[threadIdx.x] = 0u;
  if (threadIdx.x == 0) (void)xb_add(&barctr[XB_XCNT(xb_xcc_id())], 1u);
  if (p.ws == nullptr) grid.sync();
  prep_phase(p, wv);
  grid_bar(barctr, xb_words, wv);
  {
    init_xg_phase(p, wv);
    EpiSW e; e.sw = (float*)(p.ws + WS_SW);
    gemm_phase((const bf16_t*)(p.ws + WS_SH), (const bf16_t*)(p.ws + WS_W), 256, NCONS, D, e, wv);
    grid_bar(barctr, xb_words, wv);
  }
  for (int ph = 0; ph < 32; ++ph) {
    const int l = ph >> 3, s = ph & 7;
    char* ws = p.ws; asm volatile("" : "+s"(ws));
    char* W = ws + WS_W;
    const float* modl = (const float*)(ws + WS_MOD) + (size_t)l * 9 * (NMOD * D);
    const float* SW = (const float*)(ws + WS_SW); float* RS = (float*)(ws + WS_RS);
    const bool isattn = (l & 1) == 0; const int li = l >> 1;
    if (s == 0 || s == 6) {
      const int f = s == 0 ? 0 : 1;
      EpiSwiGLU es; es.act = (bf16_t*)(ws + WS_BIG); es.rs = RS + (size_t)(l * 3 + (f ? 2 : 0)) * (NTOK * 4); es.sw = SW + (l * 2 + f) * 5632;
      gemm_phase((const bf16_t*)(ws + WS_H), (const bf16_t*)(W + W_UP + (size_t)(l * 2 + f) * W_UP_STRIDE), NTOK, 5632, D, es, wv);
    } else if (s == 1 || s == 7 || s == 5) {
      const int f = s == 1 ? 0 : 1;
      const bool isout = s == 5;
      const float* gate = modl + (isout ? 5 : (f == 0 ? 2 : 8)) * D;
      const bf16_t* A = (const bf16_t*)(ws + (isout ? WS_O : WS_BIG));
      const int K = isout ? D : DFF;
      const bf16_t* Bt = (const bf16_t*)(isout ? (isattn ? (W + W_AOUT + li * W_OUT_STRIDE) : (W + W_GOUT + li * W_OUT_STRIDE)) : (W + W_DOWN + (size_t)(l * 2 + f) * W_DOWN_STRIDE));
      const int nid = isout ? l * 3 + 2 : (f == 0 ? l * 3 + 1 : (l + 1) * 3);
      const EpiResid er = {ws, gate, p.g_norm, nid};
      gemm_phase(A, Bt, NTOK, D, K, er, wv);
    } else if (s == 2) {
      const float* rsn = RS + (size_t)(l * 3 + 1) * (NTOK * 4);
      if (isattn) {
        cache_phase(p, li, wv);
        EpiPlain e; e.buf = (bf16_t*)(ws + WS_BIG); e.ldc = 2560; e.rs = rsn; e.sw = SW + 45056 + li * 2560;
        gemm_phase((const bf16_t*)(ws + WS_H), (const bf16_t*)(W + W_AIN + li * W_AIN_STRIDE), NTOK, 2560, D, e, wv);
      } else {
        EpiGlaIn e; e.buf = (bf16_t*)(ws + WS_BIG + BIG_GLABUF); e.dg = (float*)(ws + WS_BIG + BIG_DG); e.rs = rsn; e.sw = SW + 50176 + li * 3328;
        gemm_phase((const bf16_t*)(ws + WS_H), (const bf16_t*)(W + W_GIN + li * W_GIN_STRIDE), NTOK, 3328, D, e, wv);
      }
    } else if (s == 3) {
      if (isattn) qkv_post_phase(p, li, wv); else gla_phase(p, li, wv);
    } else {
      if (isattn) attn_phase(p, li, wv); else gla_post_phase(p, li, wv);
    }
    grid_bar(barctr, xb_words, wv);
  }
  norm_phase(p, p.g_final, nullptr, true, wv);
}

extern "C" void kernel_launch(void* const* d_in, const int* in_sizes, int n_in, void* d_out, int out_size, void* d_ws, size_t ws_size, hipStream_t stream) {
  constexpr size_t kDynLds = 131072;
  static int grid_blocks = 0;
  if (!grid_blocks) {
    int dev = 0, cus = 0, per_cu = 0;
    (void)hipGetDevice(&dev);
    (void)hipDeviceGetAttribute(&cus, hipDeviceAttributeMultiprocessorCount, dev);
    (void)hipFuncSetAttribute((const void*)mega, hipFuncAttributeMaxDynamicSharedMemorySize, (int)kDynLds);
    (void)hipOccupancyMaxActiveBlocksPerMultiprocessor(&per_cu, mega, 512, kDynLds);
    if (per_cu < 1) per_cu = 1;
    if (per_cu > 1) per_cu = 1;
    grid_blocks = cus * per_cu;
  }
  Params p{};
  const float** pp = (const float**)&p;
  for (int i = 0; i < 26; ++i) pp[i] = (const float*)d_in[i];
  p.out = (float*)d_out; p.ws = (char*)d_ws;
  (void)hipMemsetAsync((char*)d_ws + WS_BAR, 0, XCD_BAR_WORDS * sizeof(unsigned), stream);
  void* args[] = {&p};
  hipError_t e = hipLaunchCooperativeKernel((void*)mega, dim3(grid_blocks), dim3(512), args, kDynLds, stream);
  if (e != hipSuccess) fprintf(stderr, "cooperative launch failed: %s (grid %d)\n", hipGetErrorString(e), grid_blocks);
}
```
